# Optimizing an MI355X kernel written in HIP

```python
import math
import jax
import jax.numpy as jnp
from jax import lax
import numpy as np

D_MODEL = 2048
BATCH = 16
SEQ = 2048
DEPTH = 2
DEC_BATCH = 2
DEC_SEQ = 16384
PAST_LEN = 128

N_MIXERS = 2
N_A_LAYERS = (DEPTH + 1) // 2
N_B_LAYERS = DEPTH // 2
RWKV_HEAD = 64
RWKV_HEADS = D_MODEL // RWKV_HEAD
DECAY_LORA = 96
AAA_LORA = 96
GATE_LORA = 256
GN_EPS = 64e-5
ATT_HEAD_DIM = 128
ATT_HEADS = D_MODEL // ATT_HEAD_DIM
DILATED_GROUPS = ((128, 1), (512, 4), (2048, 16))
N_GROUPS = len(DILATED_GROUPS)
ATT_SCALE = 1.0 / math.sqrt(ATT_HEAD_DIM)
NEG_INF = -1e30
NUM_BUCKETS = 32
MAX_DISTANCE = 1024
FFN_HIDDEN = 5632
PLE_DIM = 256
NORM_EPS = 1e-6

kernel_name = "hybrid_rwkv7_dilated_attn_encoder"


def _rmsnorm(x, g):
    xf = x.astype(jnp.float32)
    y = xf * lax.rsqrt(jnp.mean(xf * xf, axis=-1, keepdims=True) + NORM_EPS)
    return (y * g.astype(jnp.float32)).astype(x.dtype)


def _wkv_scan(r, w, k, v, kk, a, reverse):
    B, T, H, N = r.shape
    xs = tuple(jnp.moveaxis(t.astype(jnp.float32), 1, 0) for t in (r, w, k, v, kk, a))

    def step(S, inp):
        r_t, w_t, k_t, v_t, kk_t, a_t = inp
        sa = jnp.einsum('bhvk,bhk->bhv', S, -kk_t)
        S = (S * w_t[:, :, None, :]
             + sa[..., None] * (kk_t * a_t)[:, :, None, :]
             + v_t[..., None] * k_t[:, :, None, :])
        return S, jnp.einsum('bhvk,bhk->bhv', S, r_t)

    S0 = jnp.zeros((B, H, N, N), jnp.float32)
    _, ys = lax.scan(step, S0, xs, reverse=reverse)
    return jnp.moveaxis(ys, 0, 1)


def _rwkv7_bidir(x, mu, w_rkv, w0, w1, w2, a0, a1, a2, g1, g2, k_k, k_a, r_k, lnx_g, lnx_b, w_o):
    B, T, D = x.shape
    H, N = RWKV_HEADS, RWKV_HEAD
    zero = jnp.zeros_like(x[:, :1])
    prev = jnp.concatenate([zero, x[:, :-1]], axis=1)
    nxt = jnp.concatenate([x[:, 1:], zero], axis=1)
    xx = 0.5 * (prev + nxt) - x
    xs = x[None] + xx[None] * mu[:, None, None, :]
    rkv = jnp.einsum('jbtd,jde->jbte', xs[:3], w_rkv)
    r, k, v = rkv[0], rkv[1], rkv[2]
    xw, xa, xg = xs[3], xs[4], xs[5]
    g = jax.nn.sigmoid(xg @ g1) @ g2

    def heads(t):
        return t.reshape(B, T, H, N)

    kk = heads(k * k_k).astype(jnp.float32)
    kk = kk * lax.rsqrt(jnp.sum(kk * kk, axis=-1, keepdims=True) + 1e-12)
    y = 0.0
    k_bonus = 0.0
    for j in range(2):
        w_log = -jax.nn.softplus(-(w0[j] + jnp.tanh(xw @ w1[j]) @ w2[j]).astype(jnp.float32)) - 0.5
        decay = jnp.exp(-jnp.exp(w_log))
        a = jax.nn.sigmoid(a0[j] + (xa @ a1[j]) @ a2[j])
        kj = k * (1.0 + (a - 1.0) * k_a)
        y = y + _wkv_scan(heads(r), heads(decay), heads(kj), heads(v), kk, heads(a), reverse=(j == 1))
        k_bonus = k_bonus + 0.5 * kj
    mean = jnp.mean(y, axis=-1, keepdims=True)
    var = jnp.mean(jnp.square(y - mean), axis=-1, keepdims=True)
    yn = ((y - mean) * lax.rsqrt(var + GN_EPS)).reshape(B, T, D) * lnx_g + lnx_b
    bonus = jnp.sum(heads(r) * heads(k_bonus) * r_k, axis=-1, keepdims=True) * heads(v)
    out = ((yn + bonus.reshape(B, T, D)) * g).astype(x.dtype)
    return out @ w_o


def _t5_bucket(rel):
    half = NUM_BUCKETS // 2
    max_exact = half // 2
    ret = jnp.where(rel > 0, half, 0)
    n = jnp.abs(rel)
    nf = jnp.maximum(n, 1).astype(jnp.float32)
    large = max_exact + (jnp.log(nf / max_exact) / math.log(MAX_DISTANCE / max_exact)
                         * (half - max_exact)).astype(jnp.int32)
    large = jnp.minimum(large, half - 1)
    return ret + jnp.where(n < max_exact, n, large)


def _rel_bias(table_g, dil, side):
    i = jnp.arange(side)[:, None]
    j = jnp.arange(3 * side)[None, :]
    rel = dil * (j - side - i)
    return jnp.transpose(table_g[_t5_bucket(rel)], (2, 0, 1))


def _dilated_group(q, k, v, bias, dil, side):
    B, T, H, dh = q.shape
    L = T // dil
    nb = -(-L // side)
    Lp = nb * side

    def cls(t):
        return t.reshape(B, L, dil, H, dh).transpose(0, 2, 1, 3, 4)

    qc = jnp.pad(cls(q), ((0, 0), (0, 0), (0, Lp - L), (0, 0), (0, 0))).reshape(B, dil, nb, side, H, dh)

    def band(t):
        tp = jnp.pad(cls(t), ((0, 0), (0, 0), (side, Lp - L + side), (0, 0), (0, 0)))
        tp = tp.reshape(B, dil, nb + 2, side, H, dh)
        return jnp.concatenate([tp[:, :, :-2], tp[:, :, 1:-1], tp[:, :, 2:]], axis=3)

    kb, vb = band(k), band(v)
    i = jnp.arange(side)[:, None]
    j = jnp.arange(3 * side)[None, :]
    off = j - side - i
    kpos = jnp.arange(nb)[:, None, None] * side + j[None] - side
    mask = (jnp.abs(off)[None] <= side) & (kpos >= 0) & (kpos < L)
    logits = jnp.einsum('bcnqhd,bcnkhd->bcnhqk', qc, kb).astype(jnp.float32) * ATT_SCALE
    logits = logits + bias[None, None, None].astype(jnp.float32)
    logits = jnp.where(mask[None, None, :, None], logits, NEG_INF)
    m = jnp.max(logits, axis=-1, keepdims=True)
    pexp = jnp.exp(logits - m)
    s = jnp.sum(pexp, axis=-1, keepdims=True)
    o = jnp.einsum('bcnhqk,bcnkhd->bcnqhd', (pexp / s).astype(v.dtype), vb)
    lse = (m + jnp.log(s))[..., 0]
    o = o.reshape(B, dil, Lp, H, dh)[:, :, :L].transpose(0, 2, 1, 3, 4).reshape(B, T, H, dh)
    lse = lse.transpose(0, 1, 2, 4, 3).reshape(B, dil, Lp, H)[:, :, :L].transpose(0, 2, 1, 3).reshape(B, T, H)
    return o, lse


def _dilated_attention(x, w_qkv, w_o, rel_table):
    B, T, D = x.shape
    qkv = (x @ w_qkv).reshape(B, T, N_GROUPS, 3, ATT_HEADS, ATT_HEAD_DIM)
    outs, lses = [], []
    for gi, (win, dil) in enumerate(DILATED_GROUPS):
        side = win // (2 * dil)
        bias = _rel_bias(rel_table[:, gi * ATT_HEADS:(gi + 1) * ATT_HEADS], dil, side)
        o, lse = _dilated_group(qkv[:, :, gi, 0], qkv[:, :, gi, 1], qkv[:, :, gi, 2], bias, dil, side)
        outs.append(o)
        lses.append(lse)
    wts = jax.nn.softmax(jnp.stack(lses), axis=0)
    o = jnp.sum(wts[..., None] * jnp.stack(outs).astype(jnp.float32), axis=0).astype(x.dtype)
    return o.reshape(B, T, D) @ w_o


def _swiglu(x, w_gu, w_down):
    h = x @ w_gu
    gate, up = h[..., :FFN_HIDDEN], h[..., FFN_HIDDEN:]
    return (jax.nn.silu(gate) * up) @ w_down


def _trunk(x, p, norm_gains, rel_bias_table, rwkv_mu, rwkv_w_rkv, rwkv_w0, rwkv_w1, rwkv_w2,
           rwkv_a0, rwkv_a1, rwkv_a2, rwkv_g1, rwkv_g2, rwkv_k_k, rwkv_k_a, rwkv_r_k,
           rwkv_lnx_g, rwkv_lnx_b, rwkv_w_o, att_w_qkv, att_w_o, ffn_w_gu, ffn_w_down,
           ple_norm, ple_w_gate, ple_w_proj):
    for i in range(DEPTH):
        g = norm_gains[i]
        h = _rmsnorm(x, g[0])
        j = i // N_MIXERS
        if i % N_MIXERS == 0:
            h = _rwkv7_bidir(h, rwkv_mu[j], rwkv_w_rkv[j], rwkv_w0[j], rwkv_w1[j], rwkv_w2[j],
                             rwkv_a0[j], rwkv_a1[j], rwkv_a2[j], rwkv_g1[j], rwkv_g2[j],
                             rwkv_k_k[j], rwkv_k_a[j], rwkv_r_k[j], rwkv_lnx_g[j], rwkv_lnx_b[j], rwkv_w_o[j])
        else:
            h = _dilated_attention(h, att_w_qkv[j], att_w_o[j], rel_bias_table)
        x = x + _rmsnorm(h, g[1])
        h = _swiglu(_rmsnorm(x, g[2]), ffn_w_gu[i], ffn_w_down[i])
        x = x + _rmsnorm(h, g[3])
        gate = jax.nn.sigmoid(_rmsnorm(x, ple_norm[i]) @ ple_w_gate[i])
        x = x + gate * (p[i] @ ple_w_proj[i])
    return x


def setup_inputs(seed: int = 0) -> dict:
    key = jax.random.key(seed)
    ks = iter(jax.random.split(key, 40))
    D, F = D_MODEL, FFN_HIDDEN

    def nrm(shape, scale):
        return jax.random.normal(next(ks), shape, jnp.float32) * scale

    def uni(shape, lo, hi):
        return jax.random.uniform(next(ks), shape, jnp.float32, minval=lo, maxval=hi)

    NA, NB = N_A_LAYERS, N_B_LAYERS
    return {
        "x_prompt": nrm((BATCH, SEQ, D), 1.0),
        "x_sample": nrm((DEC_BATCH, DEC_SEQ, D), 1.0),
        "p_prompt": nrm((DEPTH, BATCH, SEQ, PLE_DIM), 1.0),
        "p_sample": nrm((DEPTH, DEC_BATCH, DEC_SEQ, PLE_DIM), 1.0),
        "norm_gains": 1.0 + nrm((DEPTH, 4, D), 0.1),
        "rel_bias_table": nrm((NUM_BUCKETS, N_GROUPS * ATT_HEADS), 0.5),
        "rwkv_mu": uni((NA, 6, D), 0.0, 1.0),
        "rwkv_w_rkv": nrm((NA, 3, D, D), D ** -0.5),
        "rwkv_w0": uni((NA, 2, D), -3.0, 1.0),
        "rwkv_w1": nrm((NA, 2, D, DECAY_LORA), D ** -0.5),
        "rwkv_w2": nrm((NA, 2, DECAY_LORA, D), 0.5 * DECAY_LORA ** -0.5),
        "rwkv_a0": nrm((NA, 2, D), 0.5),
        "rwkv_a1": nrm((NA, 2, D, AAA_LORA), D ** -0.5),
        "rwkv_a2": nrm((NA, 2, AAA_LORA, D), 0.5 * AAA_LORA ** -0.5),
        "rwkv_g1": nrm((NA, D, GATE_LORA), D ** -0.5),
        "rwkv_g2": nrm((NA, GATE_LORA, D), GATE_LORA ** -0.5),
        "rwkv_k_k": 0.85 + nrm((NA, D), 0.1),
        "rwkv_k_a": 1.0 + nrm((NA, D), 0.1),
        "rwkv_r_k": nrm((NA, RWKV_HEADS, RWKV_HEAD), 0.1),
        "rwkv_lnx_g": 1.0 + nrm((NA, D), 0.1),
        "rwkv_lnx_b": nrm((NA, D), 0.02),
        "rwkv_w_o": nrm((NA, D, D), D ** -0.5),
        "att_w_qkv": nrm((NB, D, N_GROUPS * 3 * ATT_HEADS * ATT_HEAD_DIM), D ** -0.5),
        "att_w_o": nrm((NB, ATT_HEADS * ATT_HEAD_DIM, D), D ** -0.5),
        "ffn_w_gu": nrm((DEPTH, D, 2 * F), D ** -0.5),
        "ffn_w_down": nrm((DEPTH, F, D), F ** -0.5),
        "ple_norm": 1.0 + nrm((DEPTH, D), 0.1),
        "ple_w_gate": nrm((DEPTH, D, D), D ** -0.5),
        "ple_w_proj": nrm((DEPTH, PLE_DIM, D), PLE_DIM ** -0.5),
    }


def reference(x_prompt, x_sample, p_prompt, p_sample, norm_gains, rel_bias_table, rwkv_mu, rwkv_w_rkv,
              rwkv_w0, rwkv_w1, rwkv_w2, rwkv_a0, rwkv_a1, rwkv_a2, rwkv_g1, rwkv_g2, rwkv_k_k, rwkv_k_a,
              rwkv_r_k, rwkv_lnx_g, rwkv_lnx_b, rwkv_w_o, att_w_qkv, att_w_o, ffn_w_gu, ffn_w_down,
              ple_norm, ple_w_gate, ple_w_proj):
    weights = (norm_gains, rel_bias_table, rwkv_mu, rwkv_w_rkv, rwkv_w0, rwkv_w1, rwkv_w2,
               rwkv_a0, rwkv_a1, rwkv_a2, rwkv_g1, rwkv_g2, rwkv_k_k, rwkv_k_a, rwkv_r_k,
               rwkv_lnx_g, rwkv_lnx_b, rwkv_w_o, att_w_qkv, att_w_o, ffn_w_gu, ffn_w_down,
               ple_norm, ple_w_gate, ple_w_proj)
    y_prompt = _trunk(x_prompt, p_prompt, *weights)
    y_sample = _trunk(x_sample, p_sample, *weights)
    return (y_prompt, y_sample)
```

```cpp
#include <hip/hip_runtime.h>
#include <cstdio>
#include <cstdint>

#define GAS __attribute__((address_space(1)))
#define LAS __attribute__((address_space(3)))
#define DI __device__ __forceinline__
typedef unsigned short bf16;
typedef short bf16x8 __attribute__((ext_vector_type(8)));
typedef short s16x4 __attribute__((ext_vector_type(4)));
typedef float f32x4 __attribute__((ext_vector_type(4)));
typedef float f32x2 __attribute__((ext_vector_type(2)));
typedef unsigned u32x4 __attribute__((ext_vector_type(4)));
typedef unsigned u32x2 __attribute__((ext_vector_type(2)));

constexpr int D = 2048, FF = 5632, NQKV = 18432, PLE = 256;
constexpr int S = 16384;
constexpr int NSLAB = 4;
constexpr int NPANEL = S / 256;
constexpr float NORM_EPS = 1e-6f, GN_EPS = 64e-5f;

constexpr size_t MiB = 1u << 20;
constexpr size_t WS_CTL = 0, CTL_BYTES = 1 * MiB;
constexpr size_t WS_BIAS = 1 * MiB;
constexpr size_t WS_WSC = 1 * MiB + 64 * 1024;
constexpr int WSC_QKV = 0, WSC_GU = 18432, WSC_PG = 18432 + 2 * 11264, WSC_WO = WSC_PG + 2 * 2048, WSC_DN = WSC_WO + 2 * 2048  ;
constexpr size_t WS_WB0 = 2 * MiB;
constexpr size_t WS_WL2 = 29 * MiB;
constexpr size_t WS_WO0 = 34 * MiB;
constexpr size_t WS_WQKV = 42 * MiB;
constexpr size_t WS_WO1 = 114 * MiB;
constexpr size_t WS_WGU = 122 * MiB;
constexpr size_t WS_WDN = 210 * MiB;
constexpr size_t WS_WPG = 254 * MiB;
constexpr size_t WS_WPP = 270 * MiB;
constexpr size_t WS_HL = 272 * MiB;
constexpr size_t WS_PB = 296 * MiB;
constexpr size_t WS_LSE = 304 * MiB;
constexpr size_t WS_ASC = 307 * MiB;
constexpr size_t WS_SLOT = 308 * MiB;
constexpr size_t SLOT_BYTES = 64 * MiB;
constexpr size_t WS_PT = WS_SLOT + 13 * SLOT_BYTES;
constexpr size_t WS_END = WS_PT + 16 * MiB;
constexpr size_t SLOT_ELEMS = (size_t)S * D;

DI float bf2f(unsigned short b) { return __uint_as_float(((unsigned)b) << 16); }
DI float bflo(unsigned w) { return __uint_as_float(w << 16); }
DI float bfhi(unsigned w) { return __uint_as_float(w & 0xffff0000u); }
typedef __bf16 bf16v2_t __attribute__((ext_vector_type(2)));
DI unsigned cvt_pk_bf16(float lo, float hi) { bf16v2_t v; v.x = (__bf16)lo; v.y = (__bf16)hi; return __builtin_bit_cast(unsigned, v); }
DI unsigned short f2bf(float f) { return (unsigned short)(cvt_pk_bf16(f, 0.f) & 0xffffu); }
template <int CTRL> DI float dpp_mov(float v) { return __int_as_float(__builtin_amdgcn_update_dpp(0, __float_as_int(v), CTRL, 0xf, 0xf, true)); }
#define DPP_XOR1 0xB1
#define DPP_XOR2 0x4E
#define DPP_HMIRROR 0x141
#define DPP_MIRROR 0x140
DI float row16_sum(float v) { v += dpp_mov<DPP_XOR1>(v); v += dpp_mov<DPP_XOR2>(v); v += dpp_mov<DPP_HMIRROR>(v); v += dpp_mov<DPP_MIRROR>(v); return v; }
DI float oct_sum(float v) { v += dpp_mov<DPP_XOR1>(v); v += dpp_mov<DPP_XOR2>(v); v += dpp_mov<DPP_HMIRROR>(v); return v; }
DI float wave_sum(float v) {
    v = row16_sum(v);
    const int iv = __float_as_int(v);
    return (__int_as_float(__builtin_amdgcn_readlane(iv, 0)) + __int_as_float(__builtin_amdgcn_readlane(iv, 16))) + (__int_as_float(__builtin_amdgcn_readlane(iv, 32)) + __int_as_float(__builtin_amdgcn_readlane(iv, 48)));
}
DI float rows_sum(float v) { auto a = __builtin_amdgcn_permlane16_swap(__float_as_uint(v), __float_as_uint(v), false, false); v = __uint_as_float(a[0]) + __uint_as_float(a[1]);
    auto b = __builtin_amdgcn_permlane32_swap(__float_as_uint(v), __float_as_uint(v), false, false); return __uint_as_float(b[0]) + __uint_as_float(b[1]); }
DI float rows_max(float v) { auto a = __builtin_amdgcn_permlane16_swap(__float_as_uint(v), __float_as_uint(v), false, false); v = fmaxf(__uint_as_float(a[0]), __uint_as_float(a[1]));
    auto b = __builtin_amdgcn_permlane32_swap(__float_as_uint(v), __float_as_uint(v), false, false); return fmaxf(__uint_as_float(b[0]), __uint_as_float(b[1])); }
#define DPP_QREV 0x1B
DI float wave_sum8(const float (&v)[8], int lane) {
    const bool b0 = lane & 1, b1 = lane & 2, b2 = lane & 4;
    float t[4], u[2];
#pragma unroll
    for (int i = 0; i < 4; ++i) { const float keep = b0 ? v[i + 4] : v[i], send = b0 ? v[i] : v[i + 4]; t[i] = keep + dpp_mov<DPP_XOR1>(send); }
#pragma unroll
    for (int i = 0; i < 2; ++i) { const float keep = b1 ? t[i + 2] : t[i], send = b1 ? t[i] : t[i + 2]; u[i] = keep + dpp_mov<DPP_XOR2>(send); }
    const float keep = b2 ? u[1] : u[0], send = b2 ? u[0] : u[1];
    float w = keep + dpp_mov<DPP_QREV>(dpp_mov<DPP_HMIRROR>(send));
    w += dpp_mov<DPP_MIRROR>(dpp_mov<DPP_HMIRROR>(w));
    return rows_sum(w);
}
constexpr int bitrev3(int e) { return ((e & 1) << 2) | (e & 2) | ((e >> 2) & 1); }
DI float wave_max(float v) {
    v = fmaxf(v, dpp_mov<DPP_XOR1>(v)); v = fmaxf(v, dpp_mov<DPP_XOR2>(v)); v = fmaxf(v, dpp_mov<DPP_HMIRROR>(v)); v = fmaxf(v, dpp_mov<DPP_MIRROR>(v));
    const int iv = __float_as_int(v);
    return fmaxf(fmaxf(__int_as_float(__builtin_amdgcn_readlane(iv, 0)), __int_as_float(__builtin_amdgcn_readlane(iv, 16))), fmaxf(__int_as_float(__builtin_amdgcn_readlane(iv, 32)), __int_as_float(__builtin_amdgcn_readlane(iv, 48))));
}
DI unsigned q8(float v) { return (unsigned)__float2int_rn(v) & 0xffu; }
DI unsigned pack4_i8(float a, float b, float c, float d) { return q8(a) | (q8(b) << 8) | (q8(c) << 16) | (q8(d) << 24); }
DI float rsqrt_fast(float x) { return __builtin_amdgcn_rsqf(x); }
DI float sigmoidf_(float x) { return 1.f / (1.f + __expf(-x)); }
#define LDS_WAIT() asm volatile("s_waitcnt lgkmcnt(0)" ::: "memory")
#define VM_WAIT() asm volatile("s_waitcnt vmcnt(0)" ::: "memory")
#ifndef MK_ONE_LAUNCH
#define MK_ONE_LAUNCH 1
#endif
namespace pg8 {
#define PG8_LAS __attribute__((address_space(3)))
typedef unsigned short bf16_t;
constexpr int BM = 256, BK = 64, HALF = 128, HTB = HALF * BK * 2  , STAGE_BYTES = 8 * HTB, NXCD = 8, WGM = 8;

__host__ __device__ __forceinline__ int lds_byte(int r, int c) { const int st = (r >> 4) * 2 + (c >> 5), rr = r & 15, cc = c & 31, ob = rr * 64 + cc * 2; return st * 1024 + (ob ^ (((ob >> 9) & 1) << 5)); }
__host__ __device__ __forceinline__ void stage_rc(int b, int& R, int& C) { const int st = b / 1024, sb = b % 1024, swz = sb ^ (((sb >> 9) & 1) << 5); R = (st >> 1) * 16 + swz / 64; C = (st & 1) * 32 + (swz % 64) / 2; }
__host__ __device__ __forceinline__ int perm32(int rho) { const int n = rho >> 4, i = rho & 15; return 8 * (i >> 2) + 4 * n + (i & 3); }

typedef int i32x4 __attribute__((ext_vector_type(4)));
template <class ACC> __device__ __forceinline__ ACC mma_sel(const bf16x8& a, const bf16x8& b, const ACC& c);
template <> __device__ __forceinline__ f32x4 mma_sel<f32x4>(const bf16x8& a, const bf16x8& b, const f32x4& c) { return __builtin_amdgcn_mfma_f32_16x16x32_bf16(a, b, c, 0, 0, 0); }
template <> __device__ __forceinline__ i32x4 mma_sel<i32x4>(const bf16x8& a, const bf16x8& b, const i32x4& c) { return __builtin_amdgcn_mfma_i32_16x16x64_i8(__builtin_bit_cast(i32x4, a), __builtin_bit_cast(i32x4, b), c, 0, 0, 0); }
struct Unit { int pm, pn, aux; };
struct Gemm { const bf16_t* A; const bf16_t* Bt; int K; };

template <class Tab> struct MultiOrder {
    int G, c;
    __device__ __forceinline__ bool next(int i, Unit& u) const {
        int L = i * G + c;
#pragma unroll
        for (int j = 0; j < Tab::NP; ++j) {
            const int nM = Tab::nM(j), nN = Tab::nN(j), nwg = nM * nN;
            if (L < nwg) {
                int wgid = L; { const int q = nwg / NXCD, r = nwg % NXCD, xcd = wgid % NXCD, off = wgid / NXCD; wgid = (xcd < r ? xcd * (q + 1) : r * (q + 1) + (xcd - r) * q) + off; }
                const int nig = WGM * nN, gid = wgid / nig, fm = gid * WGM, gsz = (nM - fm) < WGM ? (nM - fm) : WGM;
                u.pm = Tab::pm0(j) + fm + ((wgid % nig) % gsz); u.pn = Tab::pn0(j) + (wgid % nig) / gsz; u.aux = j; return true;
            }
            L -= nwg;
        }
        return false;
    }
    __device__ __forceinline__ void a_ready(const Unit&) const {}
    __device__ __forceinline__ void done(const Unit&) const {}
};
template <class Epi, class Sched, bool ALIGN_EPI = false, bool SP2 = false>
__device__ __forceinline__ void gemm_phase(PG8_LAS unsigned char* lds, const Gemm g, const Sched& S, const Epi& E, const int tid) {
    const int wid = __builtin_amdgcn_readfirstlane(tid >> 6), lane = tid & 63, wr = wid >> 2, wc = wid & 3, fr = lane & 15, fq = lane >> 4;
    const int K = g.K, nt = K / BK;
    unsigned voffA[2], voffB[2];
#pragma unroll
    for (int i = 0; i < 2; ++i) { int R, C; stage_rc(tid * 16 + i * 8192, R, C); const int Rb = Epi::PERM ? ((R & ~31) + perm32(R & 31)) : R;
        voffA[i] = (unsigned)(R * K + C) * 2u; voffB[i] = (unsigned)(Rb * K + C) * 2u; }
    const size_t kstep = (size_t)(BK * 2);
    const size_t hstep = (size_t)HALF * K * 2;
    const size_t tstep = 2 * hstep;
    const unsigned ldsw = (unsigned)wid * 1024u;
    const int aoff = lds_byte(wr * 64 + fr, fq * 8), boff = lds_byte(wc * 32 + fr, fq * 8);
#define PG8_SA(b, h) (((b) * 2 + (h)) * HTB)
#define PG8_SB(b, h) ((4 + (b) * 2 + (h)) * HTB)
#define PG8_STAGE(bufoff, gbase, voff) do { _Pragma("unroll") for (int _i = 0; _i < 2; ++_i) \
        __builtin_amdgcn_global_load_lds((const unsigned*)((const char*)(gbase) + (voff)[_i]), (PG8_LAS unsigned*)(lds + (bufoff) + ldsw + _i * 8192), 16, 0, 0); } while (0)
#define PG8_LDA(dst, b, h) do { _Pragma("unroll") for (int m = 0; m < 4; ++m) _Pragma("unroll") for (int k = 0; k < 2; ++k) dst[m][k] = *(const PG8_LAS bf16x8*)(lds + PG8_SA(b, h) + aoff + m * 2048 + k * 1024); } while (0)
#define PG8_LDB(dst, b, h) do { _Pragma("unroll") for (int n = 0; n < 2; ++n) _Pragma("unroll") for (int k = 0; k < 2; ++k) dst[n][k] = *(const PG8_LAS bf16x8*)(lds + PG8_SB(b, h) + boff + n * 2048 + k * 1024); } while (0)
#define PG8_MMA(ai, bj, At, Bt) do { __builtin_amdgcn_s_setprio(1); _Pragma("unroll") for (int m = 0; m < 4; ++m) _Pragma("unroll") for (int n = 0; n < 2; ++n) _Pragma("unroll") for (int k = 0; k < 2; ++k) \
        acc[ai][bj][m][n] = mma_sel<acc_t>(Bt[n][k], At[m][k], acc[ai][bj][m][n]); __builtin_amdgcn_s_setprio(0); } while (0)
#define PG8_WAIT_V(n) asm volatile("s_waitcnt vmcnt(" #n ")" ::: "memory")
#define PG8_WAIT_L(n) asm volatile("s_waitcnt lgkmcnt(" #n ")" ::: "memory")
#define PG8_BAR __builtin_amdgcn_s_barrier()
#define PG8_SCHED __builtin_amdgcn_sched_barrier(0)
    Unit cur, nxt; int ui = 0;
    if (!S.next(0, cur)) return;
    typedef typename Epi::acc_t acc_t; acc_t acc[2][2][4][2];
#pragma unroll
    for (int a = 0; a < 2; ++a)
#pragma unroll
        for (int b = 0; b < 2; ++b)
#pragma unroll
            for (int m = 0; m < 4; ++m)
#pragma unroll
                for (int n = 0; n < 2; ++n) acc[a][b][m][n] = acc_t{};
    bf16x8 At[4][2], B0[2][2], B1[2][2];
    const char* cA = (const char*)g.A + (size_t)cur.pm * tstep; const char* cB = (const char*)g.Bt + (size_t)cur.pn * tstep;
    S.a_ready(cur);
    if constexpr (SP2) {
        PG8_STAGE(PG8_SB(0, 0), cB, voffB); PG8_STAGE(PG8_SB(0, 1), cB + hstep, voffB); PG8_STAGE(PG8_SA(0, 0), cA, voffA); PG8_STAGE(PG8_SA(0, 1), cA + hstep, voffA);
        if (wr == 1) PG8_BAR;
        PG8_WAIT_V(2); PG8_BAR;
        PG8_STAGE(PG8_SB(1, 0), cB + kstep, voffB); PG8_STAGE(PG8_SA(1, 0), cA + kstep, voffA); PG8_STAGE(PG8_SB(1, 1), cB + hstep + kstep, voffB);
        PG8_WAIT_V(6); PG8_BAR;
    } else {
        PG8_STAGE(PG8_SB(0, 0), cB, voffB); PG8_STAGE(PG8_SA(0, 0), cA, voffA); PG8_STAGE(PG8_SB(0, 1), cB + hstep, voffB); PG8_STAGE(PG8_SA(0, 1), cA + hstep, voffA);
        if (wr == 1) PG8_BAR;
        PG8_WAIT_V(4); PG8_BAR;
        PG8_STAGE(PG8_SB(1, 0), cB + kstep, voffB); PG8_STAGE(PG8_SA(1, 0), cA + kstep, voffA); PG8_STAGE(PG8_SB(1, 1), cB + hstep + kstep, voffB);
        PG8_WAIT_V(6); PG8_BAR;
    }
    for (;;) {
        const bool has_next = S.next(ui + 1, nxt);
        const char* nA = has_next ? (const char*)g.A + (size_t)nxt.pm * tstep : cA; const char* nB = has_next ? (const char*)g.Bt + (size_t)nxt.pn * tstep : cB;
        for (int t = 0; t < nt; t += 2) {
            const bool last = (t == nt - 2);
            const char* a1 = cA + (size_t)(t + 1) * kstep;
            const char* a2 = last ? nA : cA + (size_t)(t + 2) * kstep; const char* b2 = last ? nB : cB + (size_t)(t + 2) * kstep;
            const char* a3 = a2 + kstep; const char* b3 = b2 + kstep;
            if (last && has_next) S.a_ready(nxt);
            if constexpr (SP2) {
            PG8_LDB(B0, 0, 0); PG8_LDB(B1, 0, 1); PG8_SCHED; PG8_LDA(At, 0, 0); PG8_STAGE(PG8_SA(1, 1), a1 + hstep, voffA);
            PG8_WAIT_V(8); PG8_WAIT_L(0); PG8_BAR; PG8_MMA(0, 0, At, B0); PG8_MMA(0, 1, At, B1); PG8_BAR; PG8_SCHED;
            PG8_LDA(At, 0, 1); PG8_STAGE(PG8_SB(0, 0), b2, voffB); PG8_STAGE(PG8_SB(0, 1), b2 + hstep, voffB); PG8_STAGE(PG8_SA(0, 0), a2, voffA);
            PG8_WAIT_V(8); PG8_WAIT_L(0); PG8_BAR; PG8_MMA(1, 0, At, B0); PG8_MMA(1, 1, At, B1); PG8_BAR; PG8_SCHED;
            PG8_LDB(B0, 1, 0); PG8_LDB(B1, 1, 1); PG8_SCHED; PG8_LDA(At, 1, 0); PG8_STAGE(PG8_SA(0, 1), a2 + hstep, voffA);
            PG8_WAIT_V(8); PG8_WAIT_L(0); PG8_BAR; PG8_MMA(0, 0, At, B0); PG8_MMA(0, 1, At, B1); PG8_BAR; PG8_SCHED;
            PG8_LDA(At, 1, 1); PG8_STAGE(PG8_SB(1, 0), b3, voffB); PG8_STAGE(PG8_SB(1, 1), b3 + hstep, voffB); PG8_STAGE(PG8_SA(1, 0), a3, voffA);
            PG8_WAIT_V(8); PG8_WAIT_L(0); PG8_BAR; PG8_MMA(1, 0, At, B0); PG8_MMA(1, 1, At, B1); PG8_BAR; PG8_SCHED;
            } else {
            PG8_LDB(B0, 0, 0); PG8_SCHED; PG8_LDA(At, 0, 0); PG8_STAGE(PG8_SA(1, 1), a1 + hstep, voffA);
            PG8_WAIT_L(8); PG8_BAR; PG8_WAIT_L(0); PG8_MMA(0, 0, At, B0); PG8_BAR; PG8_SCHED;
            PG8_LDB(B1, 0, 1); PG8_STAGE(PG8_SB(0, 0), b2, voffB);
            PG8_BAR; PG8_WAIT_L(0); PG8_MMA(0, 1, At, B1); PG8_BAR;
            PG8_LDA(At, 0, 1); PG8_STAGE(PG8_SA(0, 0), a2, voffA);
            PG8_BAR; PG8_WAIT_L(0); PG8_MMA(1, 0, At, B0); PG8_BAR; PG8_SCHED;
            PG8_STAGE(PG8_SB(0, 1), b2 + hstep, voffB);
            PG8_WAIT_V(6); PG8_BAR; PG8_MMA(1, 1, At, B1); PG8_BAR;
            PG8_LDB(B0, 1, 0); PG8_SCHED; PG8_LDA(At, 1, 0); PG8_STAGE(PG8_SA(0, 1), a2 + hstep, voffA);
            PG8_WAIT_L(8); PG8_BAR; PG8_WAIT_L(0); PG8_MMA(0, 0, At, B0); PG8_BAR; PG8_SCHED;
            PG8_LDB(B1, 1, 1); PG8_STAGE(PG8_SB(1, 0), b3, voffB);
            PG8_BAR; PG8_WAIT_L(0); PG8_MMA(0, 1, At, B1); PG8_BAR;
            PG8_LDA(At, 1, 1); PG8_STAGE(PG8_SA(1, 0), a3, voffA);
            PG8_BAR; PG8_WAIT_L(0); PG8_MMA(1, 0, At, B0); PG8_BAR; PG8_SCHED;
            PG8_STAGE(PG8_SB(1, 1), b3 + hstep, voffB);
            PG8_WAIT_V(6); PG8_BAR; PG8_MMA(1, 1, At, B1); PG8_BAR;
            }
        }
        if constexpr (ALIGN_EPI) { if (wr == 0) PG8_BAR; }
        if constexpr (!Epi::AFTER_DRAIN) { E(acc, cur, wr, wc, fr, fq); S.done(cur); }
        if (!has_next) break;
#pragma unroll
        for (int a = 0; a < 2; ++a)
#pragma unroll
            for (int b = 0; b < 2; ++b)
#pragma unroll
                for (int m = 0; m < 4; ++m)
#pragma unroll
                    for (int n = 0; n < 2; ++n) acc[a][b][m][n] = acc_t{};
        cur = nxt; cA = nA; cB = nB; ++ui;
        if constexpr (ALIGN_EPI) { if (wr == 1) PG8_BAR; }
    }
    PG8_WAIT_V(0);
    if constexpr (!ALIGN_EPI) { if (wr == 0) PG8_BAR; }
    PG8_BAR;
    if constexpr (Epi::AFTER_DRAIN) { E.fused(acc, cur, wr, wc, fr, fq, lds, wid, lane); S.done(cur); }
#undef PG8_SA
#undef PG8_SB
#undef PG8_STAGE
#undef PG8_LDA
#undef PG8_LDB
#undef PG8_MMA
#undef PG8_WAIT_V
#undef PG8_WAIT_L
#undef PG8_BAR
#undef PG8_SCHED
}
template <int ACT> __device__ __forceinline__ float act_f(float x) {
    if (ACT == 1) return 2.f * __builtin_amdgcn_rcpf(1.f + __expf(-2.f * x)) - 1.f;
    if (ACT == 2) return 1.f * __builtin_amdgcn_rcpf(1.f + __expf(-x));
    if (ACT == 3) return -0.6065306597f * __builtin_amdgcn_rcpf(1.f + __expf(-x));
    return x;
}
template <int ACT> __device__ __forceinline__ void store_tile_bf16(const f32x4 (&acc)[2][2][4][2], bf16_t* base, int ldc, int row0, int col0, const float* bias, int bcol0) {
    f32x4 bv[2][2];
#pragma unroll
    for (int bj = 0; bj < 2; ++bj)
#pragma unroll
        for (int n = 0; n < 2; ++n) bv[bj][n] = bias ? *(const f32x4*)(bias + bcol0 + bj * HALF + 4 * n) : (f32x4){0.f, 0.f, 0.f, 0.f};
#pragma unroll
    for (int ai = 0; ai < 2; ++ai)
#pragma unroll
        for (int m = 0; m < 4; ++m) { bf16_t* rowp = base + (size_t)(row0 + ai * HALF + m * 16) * ldc + col0;
#pragma unroll
            for (int bj = 0; bj < 2; ++bj) { f32x4 v0 = acc[ai][bj][m][0] + bv[bj][0], v1 = acc[ai][bj][m][1] + bv[bj][1];
#pragma unroll
                for (int e = 0; e < 4; ++e) { v0[e] = act_f<ACT>(v0[e]); v1[e] = act_f<ACT>(v1[e]); }
                u32x4 w; w.x = cvt_pk_bf16(v0[0], v0[1]); w.y = cvt_pk_bf16(v0[2], v0[3]); w.z = cvt_pk_bf16(v1[0], v1[1]); w.w = cvt_pk_bf16(v1[2], v1[3]);
                *(u32x4*)(rowp + bj * HALF) = w; } }
}
struct EpiPlain {
    typedef f32x4 acc_t; static constexpr bool PERM = true, AFTER_DRAIN = false;
    bf16_t* O; int ldc;
    __device__ __forceinline__ void operator()(const f32x4 (&acc)[2][2][4][2], const Unit& u, int wr, int wc, int fr, int fq) const {
        store_tile_bf16<0>(acc, O, ldc, u.pm * BM + wr * 64 + fr, u.pn * BM + wc * 32 + 8 * fq, nullptr, 0);
    }
};
struct EpiL0B {
    typedef f32x4 acc_t; static constexpr bool PERM = true, AFTER_DRAIN = false;
    bf16_t* rkv; bf16_t* hl;
    __device__ __forceinline__ void operator()(const f32x4 (&acc)[2][2][4][2], const Unit& u, int wr, int wc, int fr, int fq) const {
        const int j = u.aux, pmL = u.pm - NPANEL * j;
        if (j < 3) { store_tile_bf16<0>(acc, rkv + (size_t)j * SLOT_ELEMS, D, pmL * BM + wr * 64 + fr, (u.pn - 8 * j) * BM + wc * 32 + 8 * fq, nullptr, 0); return; }
        bf16_t* base = hl + (size_t)(j - 3) * S * 256; const int row0 = pmL * BM + wr * 64 + fr, col0 = wc * 32 + 8 * fq;
        if (j == 3) store_tile_bf16<1>(acc, base, 256, row0, col0, nullptr, 0);
        else if (j == 4) store_tile_bf16<0>(acc, base, 256, row0, col0, nullptr, 0);
        else store_tile_bf16<2>(acc, base, 256, row0, col0, nullptr, 0);
    }
};
struct EpiL0C {
    typedef f32x4 acc_t; static constexpr bool PERM = true, AFTER_DRAIN = false;
    bf16_t* out; const float* w0; const float* a0;
    __device__ __forceinline__ void operator()(const f32x4 (&acc)[2][2][4][2], const Unit& u, int wr, int wc, int fr, int fq) const {
        const int p = u.aux, src = p >> 1, pmL = u.pm - NPANEL * src, pnL = u.pn - 8 * p;
        bf16_t* base = out + (size_t)p * SLOT_ELEMS; const int row0 = pmL * BM + wr * 64 + fr, col0 = pnL * BM + wc * 32 + 8 * fq;
        if (p < 2) store_tile_bf16<3>(acc, base, D, row0, col0, w0 + p * D, col0);
        else if (p < 4) store_tile_bf16<2>(acc, base, D, row0, col0, a0 + (p - 2) * D, col0);
        else store_tile_bf16<0>(acc, base, D, row0, col0, nullptr, 0);
    }
};
struct EpiSwiGLU {
    typedef f32x4 acc_t; static constexpr bool PERM = true, AFTER_DRAIN = false;
    bf16_t* O;
    __device__ __forceinline__ void operator()(const f32x4 (&acc)[2][2][4][2], const Unit& u, int wr, int wc, int fr, int fq) const {
        const int row0 = u.pm * BM + wr * 64 + fr, col0 = u.pn * HALF + wc * 32 + 8 * fq;
#pragma unroll
        for (int ai = 0; ai < 2; ++ai)
#pragma unroll
            for (int m = 0; m < 4; ++m) { bf16_t* rowp = O + (size_t)(row0 + ai * HALF + m * 16) * FF + col0;
                float h[8];
#pragma unroll
                for (int n = 0; n < 2; ++n)
#pragma unroll
                    for (int e = 0; e < 4; ++e) { const float g = acc[ai][0][m][n][e], up = acc[ai][1][m][n][e]; h[4 * n + e] = g * up * __builtin_amdgcn_rcpf(1.f + __expf(-g)); }
                u32x4 w; w.x = cvt_pk_bf16(h[0], h[1]); w.y = cvt_pk_bf16(h[2], h[3]); w.z = cvt_pk_bf16(h[4], h[5]); w.w = cvt_pk_bf16(h[6], h[7]);
                *(u32x4*)rowp = w; }
    }
};
struct EpiPleGate {
    typedef f32x4 acc_t; static constexpr bool PERM = false, AFTER_DRAIN = false;
    float* X; const bf16_t* PP;
    __device__ __forceinline__ void operator()(const f32x4 (&acc)[2][2][4][2], const Unit& u, int wr, int wc, int fr, int fq) const {
        const int row0 = u.pm * BM + wr * 64 + fr, col0 = u.pn * BM + wc * 32 + 4 * fq;
#pragma unroll
        for (int ai = 0; ai < 2; ++ai)
#pragma unroll
            for (int m = 0; m < 4; ++m) { const size_t off = (size_t)(row0 + ai * HALF + m * 16) * D + col0;
#pragma unroll
                for (int bj = 0; bj < 2; ++bj)
#pragma unroll
                    for (int n = 0; n < 2; ++n) { const size_t o2 = off + bj * HALF + n * 16; const u32x2 pw = *(const u32x2*)(PP + o2); f32x4 xv = *(const f32x4*)(X + o2); const f32x4 a = acc[ai][bj][m][n];
                        xv[0] += bflo(pw.x) * __builtin_amdgcn_rcpf(1.f + __expf(-a[0])); xv[1] += bfhi(pw.x) * __builtin_amdgcn_rcpf(1.f + __expf(-a[1])); xv[2] += bflo(pw.y) * __builtin_amdgcn_rcpf(1.f + __expf(-a[2])); xv[3] += bfhi(pw.y) * __builtin_amdgcn_rcpf(1.f + __expf(-a[3]));
                        *(f32x4*)(X + o2) = xv; } }
    }
};
struct EpiPlainI8 {
    typedef i32x4 acc_t; static constexpr bool PERM = true, AFTER_DRAIN = false;
    bf16_t* O; int ldc; const float* asc; const float* wsc;
    __device__ __forceinline__ void operator()(const i32x4 (&acc)[2][2][4][2], const Unit& u, int wr, int wc, int fr, int fq) const {
        const int row0 = u.pm * BM + wr * 64 + fr, col0 = u.pn * BM + wc * 32 + 8 * fq;
        f32x4 ws[2][2];
#pragma unroll
        for (int bj = 0; bj < 2; ++bj)
#pragma unroll
            for (int n = 0; n < 2; ++n) ws[bj][n] = *(const f32x4*)(wsc + col0 + bj * HALF + 4 * n);
        float sav[2][4];
#pragma unroll
        for (int ai = 0; ai < 2; ++ai)
#pragma unroll
            for (int m = 0; m < 4; ++m) sav[ai][m] = asc[row0 + ai * HALF + m * 16];
#pragma unroll
        for (int ai = 0; ai < 2; ++ai)
#pragma unroll
            for (int m = 0; m < 4; ++m) { const int row = row0 + ai * HALF + m * 16; const float sa = sav[ai][m]; bf16_t* rowp = O + (size_t)row * ldc + col0;
#pragma unroll
                for (int bj = 0; bj < 2; ++bj) { float v[8];
#pragma unroll
                    for (int n = 0; n < 2; ++n) { const f32x4 sw = ws[bj][n] * sa;
#pragma unroll
                        for (int e = 0; e < 4; ++e) v[4 * n + e] = (float)acc[ai][bj][m][n][e] * sw[e]; }
                    u32x4 w; w.x = cvt_pk_bf16(v[0], v[1]); w.y = cvt_pk_bf16(v[2], v[3]); w.z = cvt_pk_bf16(v[4], v[5]); w.w = cvt_pk_bf16(v[6], v[7]);
                    *(u32x4*)(rowp + bj * HALF) = w; } }
    }
};
struct EpiSwiGLUI8 {
    typedef i32x4 acc_t; static constexpr bool PERM = true, AFTER_DRAIN = false;
    bf16_t* O; const float* asc; const float* wsc;
    __device__ __forceinline__ void operator()(const i32x4 (&acc)[2][2][4][2], const Unit& u, int wr, int wc, int fr, int fq) const {
        const int row0 = u.pm * BM + wr * 64 + fr, col0 = u.pn * HALF + wc * 32 + 8 * fq, bcol0 = u.pn * BM + wc * 32 + 8 * fq;
        f32x4 ws[2][2];
#pragma unroll
        for (int bj = 0; bj < 2; ++bj)
#pragma unroll
            for (int n = 0; n < 2; ++n) ws[bj][n] = *(const f32x4*)(wsc + bcol0 + bj * HALF + 4 * n);
        float sav[2][4];
#pragma unroll
        for (int ai = 0; ai < 2; ++ai)
#pragma unroll
            for (int m = 0; m < 4; ++m) sav[ai][m] = asc[row0 + ai * HALF + m * 16];
#pragma unroll
        for (int ai = 0; ai < 2; ++ai)
#pragma unroll
            for (int m = 0; m < 4; ++m) { const int row = row0 + ai * HALF + m * 16; const float sa = sav[ai][m]; bf16_t* rowp = O + (size_t)row * FF + col0;
                float h[8];
#pragma unroll
                for (int n = 0; n < 2; ++n)
#pragma unroll
                    for (int e = 0; e < 4; ++e) { const float g = (float)acc[ai][0][m][n][e] * (sa * ws[0][n][e]), up = (float)acc[ai][1][m][n][e] * (sa * ws[1][n][e]); h[4 * n + e] = g * up * __builtin_amdgcn_rcpf(1.f + __expf(-g)); }
                u32x4 w; w.x = cvt_pk_bf16(h[0], h[1]); w.y = cvt_pk_bf16(h[2], h[3]); w.z = cvt_pk_bf16(h[4], h[5]); w.w = cvt_pk_bf16(h[6], h[7]);
                *(u32x4*)rowp = w; }
    }
};
struct EpiPleGateI8 {
    typedef i32x4 acc_t; static constexpr bool PERM = false, AFTER_DRAIN = false;
    const bf16_t* XI; bf16_t* XB; float* XF; const bf16_t* PP; const float* asc; const float* wsc;
    __device__ __forceinline__ void operator()(const i32x4 (&acc)[2][2][4][2], const Unit& u, int wr, int wc, int fr, int fq) const {
        const int row0 = u.pm * BM + wr * 64 + fr, col0 = u.pn * BM + wc * 32 + 4 * fq;
        f32x4 ws[2][2];
#pragma unroll
        for (int bj = 0; bj < 2; ++bj)
#pragma unroll
            for (int n = 0; n < 2; ++n) ws[bj][n] = *(const f32x4*)(wsc + col0 + bj * HALF + n * 16);
        float sav[2][4];
#pragma unroll
        for (int ai = 0; ai < 2; ++ai)
#pragma unroll
            for (int m = 0; m < 4; ++m) sav[ai][m] = asc[row0 + ai * HALF + m * 16];
        u32x2 pw[2][4], xw[2][4];
#define GATE_LD(buf, i) do { const size_t off_ = (size_t)(row0 + ((i) >> 2) * HALF + ((i) & 3) * 16) * D + col0; _Pragma("unroll") for (int q_ = 0; q_ < 4; ++q_) { const size_t o2_ = off_ + (q_ >> 1) * HALF + (q_ & 1) * 16; \
            pw[buf][q_] = *(const u32x2*)(PP + o2_); xw[buf][q_] = *(const u32x2*)(XI + o2_); } } while (0)
        GATE_LD(0, 0);
#pragma unroll
        for (int i = 0; i < 8; ++i) { const int ai = i >> 2, m = i & 3; const float sa = sav[ai][m]; const size_t off = (size_t)(row0 + ai * HALF + m * 16) * D + col0;
            if (i + 1 < 8) GATE_LD((i + 1) & 1, i + 1);
#pragma unroll
            for (int q = 0; q < 4; ++q) { const int bj = q >> 1, n = q & 1; const size_t o2 = off + bj * HALF + n * 16; const u32x2 pv = pw[i & 1][q], xq = xw[i & 1][q]; const i32x4 ia = acc[ai][bj][m][n]; const f32x4 wv = ws[bj][n];
                f32x4 xv = (f32x4){bflo(xq.x), bfhi(xq.x), bflo(xq.y), bfhi(xq.y)};
                xv[0] += bflo(pv.x) * __builtin_amdgcn_rcpf(1.f + __expf(-(float)ia[0] * sa * wv[0])); xv[1] += bfhi(pv.x) * __builtin_amdgcn_rcpf(1.f + __expf(-(float)ia[1] * sa * wv[1]));
                xv[2] += bflo(pv.y) * __builtin_amdgcn_rcpf(1.f + __expf(-(float)ia[2] * sa * wv[2])); xv[3] += bfhi(pv.y) * __builtin_amdgcn_rcpf(1.f + __expf(-(float)ia[3] * sa * wv[3]));
                if (XF) *(f32x4*)(XF + o2) = xv; else { u32x2 w; w.x = cvt_pk_bf16(xv[0], xv[1]); w.y = cvt_pk_bf16(xv[2], xv[3]); *(u32x2*)(XB + o2) = w; } } }
#undef GATE_LD
    }
};
struct TabL0B { static constexpr int NP = 6; static __device__ constexpr int nM(int) { return NPANEL; } static __device__ constexpr int nN(int j) { return j < 3 ? 8 : 1; }
    static __device__ constexpr int pm0(int j) { return NPANEL * j; } static __device__ constexpr int pn0(int j) { return j < 3 ? 8 * j : 24 + (j - 3); } };
struct TabL0C { static constexpr int NP = 5; static __device__ constexpr int nM(int) { return NPANEL; } static __device__ constexpr int nN(int) { return 8; }
    static __device__ constexpr int pm0(int p) { return NPANEL * (p >> 1); } static __device__ constexpr int pn0(int p) { return 8 * p; } };
template <int NN> struct TabOne { static constexpr int NP = 1; static __device__ constexpr int nM(int) { return NPANEL; } static __device__ constexpr int nN(int) { return NN; }
    static __device__ constexpr int pm0(int) { return 0; } static __device__ constexpr int pn0(int) { return 0; } };
}
typedef pg8::Unit Unit;
#define XB_TMO      128
#define XB_XCNT(j)  (256  + 64 * (j))
#define XB_XSUB(j)  (1280 + 64 * (j))
#define XB_XGEN(j)  (2304 + 64 * (j))
#define XB_TOP      3328
#define XB_TOPGEN   3392
#define XCD_BAR_WORDS 3456
#define XB_SPIN_CAP (1u << 21)

__device__ __forceinline__ unsigned xb_ld(unsigned* p)              { return __hip_atomic_load(p, __ATOMIC_RELAXED, __HIP_MEMORY_SCOPE_AGENT); }
__device__ __forceinline__ unsigned xb_add(unsigned* p, unsigned v) { return __hip_atomic_fetch_add(p, v, __ATOMIC_RELAXED, __HIP_MEMORY_SCOPE_AGENT); }
__device__ __forceinline__ unsigned xb_xcc_id() { return (unsigned)__builtin_amdgcn_s_getreg((3 << 11) | 20) & 0xFu; }
#define XB_SPIN(cond, bar) do { unsigned _sp = 0; while (cond) { __builtin_amdgcn_s_sleep(1); \
    if ((++_sp & 255u) == 0u) { if (xb_ld(&(bar)[XB_TMO])) break; if (_sp > XB_SPIN_CAP) { atomicAdd(&(bar)[XB_TMO], 1u); break; } } } } while (0)

struct XcdBarrier {
    unsigned* bar; unsigned x;
    volatile LAS unsigned* st;
    int w;
};

__device__ __forceinline__ XcdBarrier xcd_barrier_post(unsigned* bar, volatile LAS unsigned* st) {
    XcdBarrier b; b.bar = bar; b.x = xb_xcc_id(); b.st = st; b.w = 0;
    if (threadIdx.x == 0) (void)xb_add(&bar[XB_XCNT(b.x)], 1u);
    return b;
}
__device__ __forceinline__ void xcd_barrier_complete(unsigned* bar, unsigned x, unsigned& nloc, unsigned& nx) {
    const unsigned G = gridDim.x * gridDim.y * gridDim.z;
    unsigned sum, cnt, mine, sp = 0u;
    for (;;) {
        sum = 0u; cnt = 0u; mine = 0u;
#pragma unroll
        for (unsigned j = 0; j < 16; ++j) { const unsigned c = xb_ld(&bar[XB_XCNT(j)]); sum += c; cnt += (c > 0u) ? 1u : 0u; mine = (j == x) ? c : mine; }
        if (sum == G) break;
        __builtin_amdgcn_s_sleep(1);
        if ((++sp & 255u) == 0u) { if (xb_ld(&bar[XB_TMO])) break; if (sp > XB_SPIN_CAP) { atomicAdd(&bar[XB_TMO], 1u); break; } }
    }
    nloc = mine > 0u ? mine : 1u; nx = cnt > 0u ? cnt : 1u;
}

__device__ __forceinline__ void xcd_barrier(const XcdBarrier& b) {
    asm volatile("s_waitcnt vmcnt(0)" ::: "memory");
    __syncthreads();
    int ln_; asm volatile("v_mbcnt_lo_u32_b32 %0, -1, 0\n\tv_mbcnt_hi_u32_b32 %0, -1, %0" : "=v"(ln_));
    if (b.w == 0 && ln_ == 0) {
        unsigned* bar = b.bar;
        __builtin_amdgcn_s_waitcnt(0);
        unsigned nloc = b.st[0], nx = b.st[1];
        if (nloc == 0u) { xcd_barrier_complete(bar, b.x, nloc, nx); b.st[0] = nloc; b.st[1] = nx; }
        const unsigned old = xb_add(&bar[XB_XSUB(b.x)], 1u);
        const unsigned gen = old / nloc;
        if (old + 1u == (gen + 1u) * nloc) {
            __builtin_amdgcn_fence(__ATOMIC_RELEASE, "agent");
            asm volatile("s_waitcnt vmcnt(0)" ::: "memory");
            const unsigned og = xb_add(&bar[XB_TOP], 1u);
            const unsigned tg = og / nx;
            if (og + 1u == (tg + 1u) * nx) xb_add(&bar[XB_TOPGEN], 1u);
            else XB_SPIN(xb_ld(&bar[XB_TOPGEN]) == tg, bar);
            __builtin_amdgcn_fence(__ATOMIC_ACQUIRE, "agent");
            xb_add(&bar[XB_XGEN(b.x)], 1u);
            asm volatile("s_waitcnt vmcnt(0)" ::: "memory");
        } else {
            XB_SPIN(xb_ld(&bar[XB_XGEN(b.x)]) == gen, bar);
            __builtin_amdgcn_fence(__ATOMIC_ACQUIRE, "agent");
            asm volatile("s_waitcnt vmcnt(0)" ::: "memory");
        }
    }
    __syncthreads();
}
constexpr int NWAVES = 8;
constexpr int RING_BYTES = 131072, LDSCTL_OFF = RING_BYTES, MISC_OFF = LDSCTL_OFF + 320, LDS_BYTES = 147456;
constexpr int CW_BAR = 4096;

struct Args { const float* in[29]; float* out; unsigned char* ws; int slab_lo, slab_hi, ph_lo, ph_hi, use_bar, do_pro; };
typedef const __attribute__((address_space(4))) Args* ArgsP;
DI ArgsP args_ptr() { ArgsP p = (ArgsP)__builtin_amdgcn_kernarg_segment_ptr(); asm volatile("" : "+s"(p)); return p; }

struct Frame {
    LAS unsigned char* lds; unsigned char* ldsg;
    int tid, lane, wave, vcu, G, gw, NGW;
};

DI void wht8(float (&f)[8]) {
#pragma unroll
    for (int st = 4; st >= 1; st >>= 1)
#pragma unroll
        for (int i = 0; i < 8; ++i) if (!(i & st)) { const float a = f[i], b = f[i + st]; f[i] = a + b; f[i + st] = a - b; }
}
DI int w_row(int nn, int rowoff, int mode) { return mode == 1 ? (nn < FF ? 256 * (nn >> 7) + (nn & 127) : 256 * ((nn - FF) >> 7) + 128 + ((nn - FF) & 127)) : rowoff + nn; }
template <bool RANGE, bool I8> DI void tr_job(const float* src, const int K, const int N, const int klo, const int khi, void* dst, const int pitch, const int rowoff, const int mode, const float* wsc,
                                              LAS float* scr, const int gw, const int NGW, const int lane, const int rot = 0, const float* part = nullptr, float* wsc_out = nullptr) {
    const int nblk = N >> 5, nitems = (K >> 6) * nblk, r8 = lane >> 3, c4 = lane & 7, hf = lane >> 5, n = lane & 31;
    f32x4 v[8]; float scn = 0.f;
#define TR_LOAD(it_) do { const int kb_ = (it_) / nblk, nb_ = (it_) - kb_ * nblk; const float* sp_ = src + nb_ * 32 + 4 * c4; \
        _Pragma("unroll") for (int i = 0; i < 8; ++i) { const int kv = kb_ * 64 + 8 * i + r8; \
            if (RANGE) { const bool ok = kv >= klo && kv < khi; const f32x4 t_ = *(const f32x4*)(sp_ + (size_t)(ok ? kv - klo : 0) * N); v[i] = ok ? t_ : (f32x4){0.f, 0.f, 0.f, 0.f}; } \
            else v[i] = *(const f32x4*)(sp_ + (size_t)kv * N); } \
        if (I8) { const int rw_ = w_row(nb_ * 32 + n, rowoff, mode); scn = rot ? fmaxf(fmaxf(part[rw_], part[2048 + rw_]), fmaxf(part[4096 + rw_], part[6144 + rw_])) : wsc[rw_]; } } while (0)
    int it = gw; if (it < nitems) TR_LOAD(it);
    for (; it < nitems; it += NGW) {
#pragma unroll
        for (int i = 0; i < 8; ++i) *(LAS f32x4*)(scr + (8 * i + r8) * 36 + 4 * c4) = v[i];
        const float sc = scn; const int kb = it / nblk, nb = it - kb * nblk;
        if (it + NGW < nitems) TR_LOAD(it + NGW);
        LDS_WAIT(); asm volatile("" ::: "memory");
        const int row = w_row(nb * 32 + n, rowoff, mode);
        if (I8 && rot && kb == 0 && hf == 0) wsc_out[row] = sc;
        const LAS float* sp = scr + (32 * hf) * 36 + n;
        float f[32];
#pragma unroll
        for (int j = 0; j < 32; ++j) f[j] = sp[j * 36];
        if (I8 && rot) {
#pragma unroll
            for (int q = 0; q < 4; ++q) { float t[8];
#pragma unroll
                for (int e = 0; e < 8; ++e) t[e] = f[8 * q + e];
                wht8(t);
#pragma unroll
                for (int e = 0; e < 8; ++e) f[8 * q + e] = t[e]; }
#pragma unroll
            for (int q = 0; q < 2; ++q)
#pragma unroll
                for (int e = 0; e < 8; ++e) { const float a = f[16 * q + e], b = f[16 * q + 8 + e]; f[16 * q + e] = a + b; f[16 * q + 8 + e] = a - b; }
#pragma unroll
            for (int j = 0; j < 16; ++j) { const float a = f[j], b = f[j + 16]; f[j] = a + b; f[j + 16] = a - b; }
            { const float sgh = hf ? -1.f : 1.f;
#pragma unroll
              for (int j = 0; j < 32; ++j) { const unsigned own = __float_as_uint(f[j]); const auto sw = __builtin_amdgcn_permlane32_swap(own, own, false, false);
                  f[j] = __builtin_fmaf(f[j], sgh, __uint_as_float(sw[0] == own ? sw[1] : sw[0])) * 0.015625f; } } }
        if (I8) { const float inv = sc > 0.f ? 1.f / sc : 0.f; u32x4 o[2];
#pragma unroll
            for (int q = 0; q < 2; ++q) { o[q].x = pack4_i8(f[16 * q] * inv, f[16 * q + 1] * inv, f[16 * q + 2] * inv, f[16 * q + 3] * inv); o[q].y = pack4_i8(f[16 * q + 4] * inv, f[16 * q + 5] * inv, f[16 * q + 6] * inv, f[16 * q + 7] * inv);
                o[q].z = pack4_i8(f[16 * q + 8] * inv, f[16 * q + 9] * inv, f[16 * q + 10] * inv, f[16 * q + 11] * inv); o[q].w = pack4_i8(f[16 * q + 12] * inv, f[16 * q + 13] * inv, f[16 * q + 14] * inv, f[16 * q + 15] * inv); }
            unsigned char* d = (unsigned char*)dst + (size_t)row * pitch + kb * 64 + 32 * hf; *(u32x4*)d = o[0]; *(u32x4*)(d + 16) = o[1]; }
        else { bf16* d = (bf16*)dst + (size_t)row * pitch + kb * 64 + 32 * hf;
#pragma unroll
            for (int q = 0; q < 4; ++q) { u32x4 o; o.x = cvt_pk_bf16(f[8 * q], f[8 * q + 1]); o.y = cvt_pk_bf16(f[8 * q + 2], f[8 * q + 3]); o.z = cvt_pk_bf16(f[8 * q + 4], f[8 * q + 5]); o.w = cvt_pk_bf16(f[8 * q + 6], f[8 * q + 7]); *(u32x4*)(d + 8 * q) = o; } }
        LDS_WAIT(); asm volatile("" ::: "memory");
    }
#undef TR_LOAD
}
DI void col_absmax_strip(const float* src, int K, int N, int rowoff, int mode, float* wsc, int strip, int lane) {
    const int n0 = strip * 32, r8 = lane >> 3, c4 = lane & 7; const float* sp = src + n0 + 4 * c4;
    f32x4 m = (f32x4){0.f, 0.f, 0.f, 0.f};
    f32x4 cur[8];
#pragma unroll
    for (int i = 0; i < 8; ++i) cur[i] = *(const f32x4*)(sp + (size_t)(r8 + 8 * i) * N);
    for (int k = r8; k < K; k += 64) { f32x4 nxt[8]; const bool more = k + 64 < K;
        if (more) {
#pragma unroll
            for (int i = 0; i < 8; ++i) nxt[i] = *(const f32x4*)(sp + (size_t)(k + 64 + 8 * i) * N); }
#pragma unroll
        for (int i = 0; i < 8; ++i)
#pragma unroll
            for (int e = 0; e < 4; ++e) m[e] = fmaxf(m[e], fabsf(cur[i][e]));
        if (more) {
#pragma unroll
            for (int i = 0; i < 8; ++i) cur[i] = nxt[i]; } }
#pragma unroll
    for (int e = 0; e < 4; ++e) { float x = m[e]; x = fmaxf(x, dpp_mov<DPP_MIRROR>(dpp_mov<DPP_HMIRROR>(x))); m[e] = rows_max(x); }
    if (lane < 8) {
#pragma unroll
        for (int e = 0; e < 4; ++e) wsc[w_row(n0 + 4 * lane + e, rowoff, mode)] = m[e] * (1.f / 127.f); }
}
DI void col_absmax_strip_rot(const float* src_, int K, int N, int rowoff, int mode, float* wsc, int strip, int lane, int kbeg) {
    const float* src = src_ + (size_t)kbeg * N;
    const int n0 = strip * 32, r8 = lane >> 3, c4 = lane & 7; const float* sp = src + n0 + 4 * c4 + (size_t)(8 * r8) * N;
    f32x4 m = (f32x4){0.f, 0.f, 0.f, 0.f}; const float sg2 = (r8 & 1) ? -1.f : 1.f, sg4 = (r8 & 2) ? -1.f : 1.f, sg8 = (r8 & 4) ? -1.f : 1.f;
    f32x4 cur[8];
#pragma unroll
    for (int i = 0; i < 8; ++i) cur[i] = *(const f32x4*)(sp + (size_t)i * N);
    for (int k = 0; k < K; k += 64) { f32x4 nxt[8]; const bool more = k + 64 < K;
        if (more) {
#pragma unroll
            for (int i = 0; i < 8; ++i) nxt[i] = *(const f32x4*)(sp + (size_t)(k + 64 + i) * N); }
#pragma unroll
        for (int e = 0; e < 4; ++e) { float t[8];
#pragma unroll
            for (int i = 0; i < 8; ++i) t[i] = cur[i][e];
            wht8(t);
#pragma unroll
            for (int i = 0; i < 8; ++i) { const float pr = dpp_mov<DPP_MIRROR>(dpp_mov<DPP_HMIRROR>(t[i])); const float v1 = __builtin_fmaf(t[i], sg2, pr);
                const unsigned own = __float_as_uint(v1); const auto sw = __builtin_amdgcn_permlane16_swap(own, own, false, false); const float p16 = __uint_as_float(sw[0] == own ? sw[1] : sw[0]);
                const float v2 = __builtin_fmaf(v1, sg4, p16); const unsigned own2 = __float_as_uint(v2); const auto sw2 = __builtin_amdgcn_permlane32_swap(own2, own2, false, false);
                m[e] = fmaxf(m[e], fabsf(__builtin_fmaf(v2, sg8, __uint_as_float(sw2[0] == own2 ? sw2[1] : sw2[0])))); } }
        if (more) {
#pragma unroll
            for (int i = 0; i < 8; ++i) cur[i] = nxt[i]; } }
#pragma unroll
    for (int e = 0; e < 4; ++e) { float x = m[e] * 0.015625f; x = fmaxf(x, dpp_mov<DPP_MIRROR>(dpp_mov<DPP_HMIRROR>(x))); m[e] = rows_max(x); }
    if (lane < 8) {
#pragma unroll
        for (int e = 0; e < 4; ++e) wsc[w_row(n0 + 4 * lane + e, rowoff, mode)] = m[e] * (1.f / 127.f); }
}
struct Job { const float* src; int K, N, klo, khi; bf16* dst; int pitch, rowoff, mode, range, i8, rot; float* wsc; float* part; };
constexpr int NJOBS = 24;
DI Job get_job(int j, ArgsP ap) {
    unsigned char* ws = ap->ws; Job b; b.klo = 0; b.mode = 0; b.range = 0; b.rowoff = 0; b.i8 = 0; b.rot = 0; b.wsc = nullptr; b.part = nullptr; float* WSC = (float*)(ws + WS_WSC);
    bf16* WB0 = (bf16*)(ws + WS_WB0); bf16* WL2 = (bf16*)(ws + WS_WL2);
    if (j < 3) { b.src = ap->in[7] + (size_t)j * D * D; b.K = D; b.N = D; b.dst = WB0; b.pitch = D; b.rowoff = D * j; }
    else if (j < 5) { const int d = j - 3; b.src = ap->in[9] + (size_t)d * D * 96; b.K = D; b.N = 96; b.dst = WB0; b.pitch = D; b.rowoff = 6144 + 96 * d; }
    else if (j < 7) { const int d = j - 5; b.src = ap->in[12] + (size_t)d * D * 96; b.K = D; b.N = 96; b.dst = WB0; b.pitch = D; b.rowoff = 6144 + 256 + 96 * d; }
    else if (j == 7) { b.src = ap->in[14]; b.K = D; b.N = 256; b.dst = WB0; b.pitch = D; b.rowoff = 6144 + 512; }
    else if (j < 10) { const int d = j - 8; b.src = ap->in[10] + (size_t)d * 96 * D; b.K = 256; b.N = D; b.klo = 96 * d; b.range = 1; b.dst = WL2 + (size_t)d * D * 256; b.pitch = 256; }
    else if (j < 12) { const int d = j - 10; b.src = ap->in[13] + (size_t)d * 96 * D; b.K = 256; b.N = D; b.klo = 96 * d; b.range = 1; b.dst = WL2 + (size_t)(2 + d) * D * 256; b.pitch = 256; }
    else if (j == 12) { b.src = ap->in[15]; b.K = 256; b.N = D; b.dst = WL2 + (size_t)4 * D * 256; b.pitch = 256; }
    else if (j == 13) { b.src = ap->in[21]; b.K = D; b.N = D; b.dst = (bf16*)(ws + WS_WO0); b.pitch = D; }
    else if (j == 14) { b.src = ap->in[22]; b.K = D; b.N = NQKV; b.dst = (bf16*)(ws + WS_WQKV); b.pitch = D; b.i8 = 1; b.wsc = WSC + WSC_QKV; }
    else if (j == 15) { b.src = ap->in[23]; b.K = D; b.N = D; b.dst = (bf16*)(ws + WS_WO1); b.pitch = D; b.i8 = 1; b.wsc = WSC + WSC_WO + D; }
    else if (j < 18) { const int l = j - 16; b.src = ap->in[24] + (size_t)l * D * 2 * FF; b.K = D; b.N = 2 * FF; b.dst = (bf16*)(ws + WS_WGU) + (size_t)l * FF * D  ; b.pitch = D; b.mode = 1; b.i8 = 1; b.wsc = WSC + WSC_GU + l * 2 * FF; }
    else if (j < 20) { const int l = j - 18; b.src = ap->in[25] + (size_t)l * FF * D; b.K = FF; b.N = D; b.dst = (bf16*)(ws + WS_WDN) + (size_t)l * D * FF; b.pitch = FF; b.i8 = 1; b.rot = 1; b.wsc = WSC + WSC_DN + (l ? 0 : 2048); b.part = WSC + WSC_DN + 4096 + (l ? 0 : 8192); }
    else if (j < 22) { const int l = j - 20; b.src = ap->in[27] + (size_t)l * D * D; b.K = D; b.N = D; b.dst = (bf16*)(ws + WS_WPG) + (size_t)l * D * D / 2  ; b.pitch = D; b.i8 = 1; b.wsc = WSC + WSC_PG + l * D; }
    else { const int l = j - 22; b.src = ap->in[28] + (size_t)l * PLE * D; b.K = PLE; b.N = D; b.dst = (bf16*)(ws + WS_WPP) + (size_t)l * D * PLE; b.pitch = PLE; }
    b.khi = b.range ? b.klo + 96 : b.K;
    return b;
}
DI int t5_bucket(int rel) {
    const int ret = rel > 0 ? 16 : 0; const int n = rel < 0 ? -rel : rel;
    if (n < 8) return ret + n;
    int large = 8 + (int)(logf((float)n / 8.f) / logf(128.f) * 8.f); large = large < 15 ? large : 15;
    return ret + large;
}
DI int job_order(int i) { return i < 4 ? 14 + i : (i < 6 ? 16 + i : (i == 6 ? 19 : (i == 7 ? 18 : (i < 22 ? i - 8 : i)))); }
DI void p0_scales(const Frame& F) {
    int base = 0;
    for (int i = 7; i >= 0; --i) {
        const Job b = get_job(job_order(i), args_ptr());
        if (!b.i8) continue;
        const int ns = b.rot ? (b.N >> 5) * 4 : (b.N >> 5); int g0 = F.gw - base % F.NGW; g0 += g0 < 0 ? F.NGW : 0;
        if (b.rot) { for (int it = g0; it < ns; it += F.NGW) col_absmax_strip_rot(b.src, b.K >> 2, b.N, b.rowoff, b.mode, b.part + (it & 3) * 2048, it >> 2, F.lane, (it & 3) * (b.K >> 2)); }
        else for (int st = g0; st < ns; st += F.NGW) col_absmax_strip(b.src, b.K, b.N, b.rowoff, b.mode, b.wsc, st, F.lane);
        base += ns;
    }
}
DI void p0_prologue(const Frame& F) {
    LAS float* scr = (LAS float*)(F.lds + F.wave * 9216);
    int base = 0;
    for (int i = 0; i < NJOBS; ++i) {
        const Job b = get_job(job_order(i), args_ptr());
        int g0 = F.gw - base % F.NGW; g0 += g0 < 0 ? F.NGW : 0;
        if (b.i8) tr_job<false, true>(b.src, b.K, b.N, b.klo, b.khi, b.dst, b.pitch, b.rowoff, b.mode, b.wsc, scr, g0, F.NGW, F.lane, b.rot, b.part, b.wsc);
        else if (b.range) tr_job<true, false>(b.src, b.K, b.N, b.klo, b.khi, b.dst, b.pitch, b.rowoff, b.mode, b.wsc, scr, g0, F.NGW, F.lane);
        else tr_job<false, false>(b.src, b.K, b.N, b.klo, b.khi, b.dst, b.pitch, b.rowoff, b.mode, b.wsc, scr, g0, F.NGW, F.lane);
        base += (b.K >> 6) * (b.N >> 5);
    }
    { ArgsP ap = args_ptr(); bf16* WB0 = (bf16*)(ap->ws + WS_WB0); const int gt = F.vcu * 512 + F.tid, NT = F.G * 512;
      for (int i = gt; i < 2 * 64 * D / 8; i += NT) { const int blk = i / (64 * D / 8), r = i % (64 * D / 8); *(u32x4*)(WB0 + (size_t)(6144 + 256 * blk + 192) * D + (size_t)r * 8) = (u32x4){0u, 0u, 0u, 0u}; }
      float* bt = (float*)(ap->ws + WS_BIAS); const float* tab = ap->in[5];
      for (int i = gt; i < 3 * 16 * 129; i += NT) { const int o = i % 129 - 64, gh = i / 129, gi = gh >> 4; const int dil = gi == 0 ? 1 : (gi == 1 ? 4 : 16);
          bt[i] = tab[t5_bucket(dil * o) * 48 + gh]; } }
}

DI void phase_mix(const Frame& F, const float* x, int Tseq, const float* g, const float* mu, bf16* xs) {
    for (int blk = F.gw; blk < S / 8; blk += F.NGW) {
        const int t0 = blk * 8;
        const bool has_prev = (t0 % Tseq) != 0, has_next = ((t0 + 8) % Tseq) != 0;
        float rs[10];
#pragma unroll
        for (int i = 0; i < 10; ++i) {
            int t = t0 - 1 + i; const bool ok = (i == 0) ? has_prev : ((i == 9) ? has_next : true); t = ok ? t : t0;
            const f32x4* xr = (const f32x4*)(x + (size_t)t * D) + F.lane; float s = 0.f;
#pragma unroll
            for (int jj = 0; jj < 8; ++jj) { const f32x4 v = xr[64 * jj]; s += (v.x * v.x + v.y * v.y) + (v.z * v.z + v.w * v.w); }
            s = wave_sum(s); rs[i] = ok ? rsqrt_fast(s * (1.f / D) + NORM_EPS) : 0.f;
        }
        const int tp = has_prev ? t0 - 1 : t0, tn = has_next ? t0 + 8 : t0;
#pragma unroll 1
        for (int jj = 0; jj < 8; ++jj) {
            const int col = 256 * jj + 4 * F.lane;
            const f32x4 g4 = *(const f32x4*)(g + col);
            f32x4 m4[6];
#pragma unroll
            for (int j = 0; j < 6; ++j) m4[j] = *(const f32x4*)(mu + j * D + col);
            f32x4 hp = *(const f32x4*)(x + (size_t)tp * D + col) * rs[0] * g4;
            f32x4 hc = *(const f32x4*)(x + (size_t)t0 * D + col) * rs[1] * g4;
#pragma unroll
            for (int i = 0; i < 8; ++i) {
                const int tt = (i == 7) ? tn : t0 + i + 1;
                const f32x4 hn = *(const f32x4*)(x + (size_t)tt * D + col) * rs[i + 2] * g4;
                const f32x4 xx = (hp + hn) * 0.5f - hc;
#pragma unroll
                for (int j = 0; j < 6; ++j) { const f32x4 o = hc + xx * m4[j]; u32x2 w; w.x = cvt_pk_bf16(o.x, o.y); w.y = cvt_pk_bf16(o.z, o.w);
                    *(u32x2*)(xs + (size_t)j * SLOT_ELEMS + (size_t)(t0 + i) * D + col) = w; }
                hp = hc; hc = hn;
            }
        }
    }
}
template <bool HAS_O, bool XF32> DI void phase_resnorm(const Frame& F, const void* xold_, bf16* xnew, const bf16* o, const float* ga, const float* gb, unsigned char* hout, float* asc, const float* p, bf16* pb) {
    for (int row = F.gw; row < S; row += F.NGW) {
        f32x4 xv[8];
#pragma unroll
        for (int jj = 0; jj < 4; ++jj) {
            if (XF32) { const f32x4* xr = (const f32x4*)((const float*)xold_ + (size_t)row * D + 512 * jj + 8 * F.lane); xv[2 * jj] = xr[0]; xv[2 * jj + 1] = xr[1]; }
            else { const u32x4 w = *(const u32x4*)((const bf16*)xold_ + (size_t)row * D + 512 * jj + 8 * F.lane);
                xv[2 * jj] = (f32x4){bflo(w.x), bfhi(w.x), bflo(w.y), bfhi(w.y)}; xv[2 * jj + 1] = (f32x4){bflo(w.z), bfhi(w.z), bflo(w.w), bfhi(w.w)}; } }
        if (HAS_O) {
            float ov[32]; float s = 0.f;
#pragma unroll
            for (int jj = 0; jj < 4; ++jj) { const u32x4 w = *(const u32x4*)(o + (size_t)row * D + 512 * jj + 8 * F.lane);
                ov[8 * jj + 0] = bflo(w.x); ov[8 * jj + 1] = bfhi(w.x); ov[8 * jj + 2] = bflo(w.y); ov[8 * jj + 3] = bfhi(w.y); ov[8 * jj + 4] = bflo(w.z); ov[8 * jj + 5] = bfhi(w.z); ov[8 * jj + 6] = bflo(w.w); ov[8 * jj + 7] = bfhi(w.w); }
#pragma unroll
            for (int e = 0; e < 32; ++e) s += ov[e] * ov[e];
            s = wave_sum(s); const float rstd = rsqrt_fast(s * (1.f / D) + NORM_EPS);
#pragma unroll
            for (int jj = 0; jj < 4; ++jj) { const f32x4* gr = (const f32x4*)(ga + 512 * jj + 8 * F.lane); const f32x4 g0 = gr[0], g1 = gr[1];
#pragma unroll
                for (int e = 0; e < 4; ++e) { xv[2 * jj][e] += ov[8 * jj + e] * rstd * g0[e]; xv[2 * jj + 1][e] += ov[8 * jj + 4 + e] * rstd * g1[e]; } }
#pragma unroll
            for (int jj = 0; jj < 4; ++jj) { u32x4 w; w.x = cvt_pk_bf16(xv[2 * jj].x, xv[2 * jj].y); w.y = cvt_pk_bf16(xv[2 * jj].z, xv[2 * jj].w); w.z = cvt_pk_bf16(xv[2 * jj + 1].x, xv[2 * jj + 1].y); w.w = cvt_pk_bf16(xv[2 * jj + 1].z, xv[2 * jj + 1].w);
                *(u32x4*)(xnew + (size_t)row * D + 512 * jj + 8 * F.lane) = w; }
        }
        float s2 = 0.f;
#pragma unroll
        for (int q = 0; q < 8; ++q) s2 += (xv[q].x * xv[q].x + xv[q].y * xv[q].y) + (xv[q].z * xv[q].z + xv[q].w * xv[q].w);
        s2 = wave_sum(s2); const float rstd2 = rsqrt_fast(s2 * (1.f / D) + NORM_EPS);
        float mx = 0.f;
#pragma unroll
        for (int jj = 0; jj < 4; ++jj) { const f32x4* gr = (const f32x4*)(gb + 512 * jj + 8 * F.lane); xv[2 * jj] = xv[2 * jj] * rstd2 * gr[0]; xv[2 * jj + 1] = xv[2 * jj + 1] * rstd2 * gr[1];
#pragma unroll
            for (int e = 0; e < 4; ++e) mx = fmaxf(mx, fmaxf(fabsf(xv[2 * jj][e]), fabsf(xv[2 * jj + 1][e]))); }
        mx = wave_max(mx); const float inv = mx > 0.f ? 127.f / mx : 0.f;
#pragma unroll
        for (int jj = 0; jj < 4; ++jj) { const f32x4 a = xv[2 * jj] * inv, b = xv[2 * jj + 1] * inv; u32x2 w; w.x = pack4_i8(a.x, a.y, a.z, a.w); w.y = pack4_i8(b.x, b.y, b.z, b.w);
            *(u32x2*)(hout + (size_t)row * D + 512 * jj + 8 * F.lane) = w; }
        if (F.lane == 0) asc[row] = mx * (1.f / 127.f);
        if (p) { const f32x4 pv = *(const f32x4*)(p + (size_t)row * PLE + 4 * F.lane); u32x2 w; w.x = cvt_pk_bf16(pv.x, pv.y); w.y = cvt_pk_bf16(pv.z, pv.w); *(u32x2*)(pb + (size_t)row * PLE + 4 * F.lane) = w; }
    }
}
DI void unpack8(const u32x4 w, float (&f)[8]) { f[0] = bflo(w.x); f[1] = bfhi(w.x); f[2] = bflo(w.y); f[3] = bfhi(w.y); f[4] = bflo(w.z); f[5] = bfhi(w.z); f[6] = bflo(w.w); f[7] = bfhi(w.w); }
DI void phase_quant_hidden(const Frame& F, const bf16* hid, unsigned char* out, float* asc) {
    for (int row = F.gw; row < S; row += F.NGW) {
        u32x4 w[11]; float mx = 0.f;
#pragma unroll
        for (int c = 0; c < 11; ++c) w[c] = *(const u32x4*)(hid + (size_t)row * FF + (c * 64 + F.lane) * 8);
        const float sg2 = (F.lane & 1) ? -1.f : 1.f, sg4 = (F.lane & 2) ? -1.f : 1.f, sg8 = (F.lane & 4) ? -1.f : 1.f;
#pragma unroll
        for (int c = 0; c < 11; ++c) { float f[8]; unpack8(w[c], f); wht8(f);
#pragma unroll
            for (int e = 0; e < 8; ++e) { f[e] = __builtin_fmaf(f[e], sg2, dpp_mov<DPP_XOR1>(f[e])); f[e] = __builtin_fmaf(f[e], sg4, dpp_mov<DPP_XOR2>(f[e])); f[e] = __builtin_fmaf(f[e], sg8, dpp_mov<DPP_QREV>(dpp_mov<DPP_HMIRROR>(f[e]))); mx = fmaxf(mx, fabsf(f[e])); } }
        mx = wave_max(mx); const float inv = mx > 0.f ? 127.f / mx : 0.f;
#pragma unroll
        for (int c = 0; c < 11; ++c) { float f[8]; unpack8(w[c], f); wht8(f);
#pragma unroll
            for (int e = 0; e < 8; ++e) { f[e] = __builtin_fmaf(f[e], sg2, dpp_mov<DPP_XOR1>(f[e])); f[e] = __builtin_fmaf(f[e], sg4, dpp_mov<DPP_XOR2>(f[e])); f[e] = __builtin_fmaf(f[e], sg8, dpp_mov<DPP_QREV>(dpp_mov<DPP_HMIRROR>(f[e]))); }
            u32x2 o; o.x = pack4_i8(f[0] * inv, f[1] * inv, f[2] * inv, f[3] * inv); o.y = pack4_i8(f[4] * inv, f[5] * inv, f[6] * inv, f[7] * inv);
            *(u32x2*)(out + (size_t)row * FF + (c * 64 + F.lane) * 8) = o; }
        if (F.lane == 0) asc[row] = mx * (1.f / 127.f);
    }
}
DI void phase_post(const Frame& F, const bf16* y0, const bf16* y1, const bf16* v, const bf16* g, const float* BON, const float* lnx_g, const float* lnx_b, bf16* out) {
    for (int row = F.gw; row < S; row += F.NGW) {
#pragma unroll 1
        for (int jj = 0; jj < 4; ++jj) {
            const size_t e0 = (size_t)row * D + 512 * jj + 8 * F.lane; const int c0 = 512 * jj + 8 * F.lane;
            float fy0[8], fy1[8], fv[8], fg[8];
            unpack8(*(const u32x4*)(y0 + e0), fy0); unpack8(*(const u32x4*)(y1 + e0), fy1); unpack8(*(const u32x4*)(v + e0), fv); unpack8(*(const u32x4*)(g + e0), fg);
            const float bs = 0.5f * (BON[(size_t)row * 32 + (c0 >> 6)] + BON[(size_t)S * 32 + (size_t)row * 32 + (c0 >> 6)]);
            float lg[8], lb[8];
            *(f32x4*)&lg[0] = *(const f32x4*)(lnx_g + c0); *(f32x4*)&lg[4] = *(const f32x4*)(lnx_g + c0 + 4); *(f32x4*)&lb[0] = *(const f32x4*)(lnx_b + c0); *(f32x4*)&lb[4] = *(const f32x4*)(lnx_b + c0 + 4);
            float y[8], s = 0.f;
#pragma unroll
            for (int e = 0; e < 8; ++e) { y[e] = fy0[e] + fy1[e]; s += y[e]; }
            s = oct_sum(s);
            const float mean = s * (1.f / 64.f); float q = 0.f;
#pragma unroll
            for (int e = 0; e < 8; ++e) { y[e] -= mean; q += y[e] * y[e]; }
            q = oct_sum(q);
            const float rstd = rsqrt_fast(q * (1.f / 64.f) + GN_EPS);
            float o[8];
#pragma unroll
            for (int e = 0; e < 8; ++e) o[e] = (y[e] * rstd * lg[e] + lb[e] + bs * fv[e]) * fg[e];
            u32x4 w; w.x = cvt_pk_bf16(o[0], o[1]); w.y = cvt_pk_bf16(o[2], o[3]); w.z = cvt_pk_bf16(o[4], o[5]); w.w = cvt_pk_bf16(o[6], o[7]);
            *(u32x4*)(out + e0) = w;
        }
    }
}
constexpr int WK_A = 0, WK_R = 4608, WK_B = 9216, WK_K = 13824, WK_BH = 18432, WK_KH = 23552, WK_VT = 28672,
              WK_TT = 33792, WK_AAK = 36352, WK_ARB = 38912, WK_ARK = 41472, WK_A10 = 44032  ,
              WK_RAW = 44544  , WK_GROUP = 65536,
              WK_SMALL = 131072 + 1024  ;
constexpr int ST64 = 144, ST32 = 80;
DI bf16x8 frag_nat(const LAS unsigned char* p) { return *(const LAS bf16x8*)p; }
DI bf16x8 frag_perm(const LAS unsigned char* p) { const s16x4 lo = *(const LAS s16x4*)p, hi = *(const LAS s16x4*)(p + 32); return (bf16x8){lo[0], lo[1], lo[2], lo[3], hi[0], hi[1], hi[2], hi[3]}; }
DI bf16x8 pack_acc(const f32x4& a, const f32x4& b) { u32x4 w; w.x = cvt_pk_bf16(a[0], a[1]); w.y = cvt_pk_bf16(a[2], a[3]); w.z = cvt_pk_bf16(b[0], b[1]); w.w = cvt_pk_bf16(b[2], b[3]); return __builtin_bit_cast(bf16x8, w); }
#define MFMA16(a, b, c) __builtin_amdgcn_mfma_f32_16x16x32_bf16((a), (b), (c), 0, 0, 0)

template <int MODE> DI void phase_wkv(const Frame& F, int nseq, const bf16* R, const bf16* K, const bf16* V, const bf16* LW, const float* k_k, const float* k_a, const float* r_k, bf16* Y, float* PT, bf16* MB, float* BON) {
    const int lane = F.lane, l15 = lane & 15, g = lane >> 4, wq = F.wave & 3, grp = F.wave >> 2, tg = F.tid & 255;
    const int Tseq = S / nseq;
    LAS unsigned char* gb = F.lds + grp * WK_GROUP;
    LAS float* CWP = (LAS float*)(F.lds + WK_SMALL + grp * 1280); LAS float* WC = CWP + 256;
    const f32x4 zero4 = (f32x4){0.f, 0.f, 0.f, 0.f};
    for (int task = F.vcu * 2 + grp; task < 512; task += F.G * 2) {
        int seq, head, dir, seg;
        if (nseq == 8) { seq = task >> 6; head = (task >> 1) & 31; dir = task & 1; seg = 0; }
        else { const int chain = task >> 3; seq = 0; head = chain >> 1; dir = chain & 1; seg = task & 7; }
        const size_t seqbase = (size_t)seq * Tseq;
        const bf16* lwp = LW + (size_t)dir * SLOT_ELEMS; const bf16* alp = LW + (size_t)(2 + dir) * SLOT_ELEMS; bf16* yo = Y + (size_t)dir * SLOT_ELEMS;
        const int hc = head * 64;
        const float kkw = k_k[hc + lane], kaw = k_a[hc + lane], rkw = r_k[hc + lane];
        float* bon = BON + (size_t)dir * S * 32 + head;
        f32x4 st[4], sid[4];
#pragma unroll
        for (int m = 0; m < 4; ++m) { st[m] = zero4;
#pragma unroll
            for (int e = 0; e < 4; ++e) sid[m][e] = (16 * m + 4 * g + e == 16 * wq + l15) ? 1.f : 0.f; }
        if (MODE == 0 && seg > 0) {
            for (int j = 0; j < seg; ++j) {
                const float* Pi = PT + (size_t)((task & ~7) + j) * 8192; const float* Th = Pi + 4096;
                bf16x8 sf[2]; sf[0] = pack_acc(st[0], st[1]); sf[1] = pack_acc(st[2], st[3]);
#pragma unroll
                for (int m = 0; m < 4; ++m) { f32x4 nw;
#pragma unroll
                    for (int e = 0; e < 4; ++e) nw[e] = Th[(16 * m + 4 * g + e) * 64 + 16 * wq + l15];
#pragma unroll
                    for (int ks = 0; ks < 2; ++ks) { const float* pr = Pi + (16 * m + l15) * 64 + 32 * ks + 4 * g; const f32x4 lo = *(const f32x4*)pr, hi = *(const f32x4*)(pr + 16);
                        nw = MFMA16(pack_acc(lo, hi), sf[ks], nw); }
                    st[m] = nw; }
            }
        }
        u32x4 raw[5];
#define WK_LOAD(ch) do { const int sg = seg * 2048 + (ch) * 32 + (tg >> 3), t = dir ? Tseq - 1 - sg : sg; const size_t el = (seqbase + t) * D + hc + 8 * (tg & 7); \
            raw[0] = *(const u32x4*)(R + el); raw[1] = *(const u32x4*)(K + el); raw[2] = *(const u32x4*)(V + el); raw[3] = *(const u32x4*)(lwp + el); raw[4] = *(const u32x4*)(alp + el); } while (0)
        WK_LOAD(0);
#pragma unroll
        for (int x = 0; x < 5; ++x) *(LAS u32x4*)(gb + WK_RAW + x * 4096 + tg * 16) = raw[x];
        WK_LOAD(1);
        __syncthreads();
#pragma unroll 1
        for (int ch = 0; ch < 64; ++ch) {
            int ln_ = F.lane; if (MODE != 0) asm volatile("" : "+v"(ln_)); const int lane = ln_, l15 = ln_ & 15, g = ln_ >> 4; const int tg = (F.tid & 192) | ln_;
            unsigned short r8[8], k8[8], v8[8], w8[8], a8[8];
            {
              LAS unsigned char* rp = gb + WK_RAW + (8 * wq + ((lane >> 2) & 3)) * 128 + ((lane >> 4) * 16 + (lane & 3) * 4) * 2;
#define WK_TR(dst, x) do { const s16x4 lo_ = __builtin_amdgcn_ds_read_tr16_b64_v4i16((LAS s16x4*)(rp + (x) * 4096)), hi_ = __builtin_amdgcn_ds_read_tr16_b64_v4i16((LAS s16x4*)(rp + (x) * 4096 + 512)); \
                  _Pragma("unroll") for (int q_ = 0; q_ < 4; ++q_) { dst[q_] = (unsigned short)lo_[q_]; dst[4 + q_] = (unsigned short)hi_[q_]; } } while (0)
              WK_TR(r8, 0); WK_TR(k8, 1); WK_TR(v8, 2); WK_TR(w8, 3); WK_TR(a8, 4);
#undef WK_TR
            }
            float lwf[8], cl[8]; float run = 0.f;
#pragma unroll
            for (int e = 0; e < 8; ++e) { lwf[e] = bf2f(w8[e]); run += lwf[e]; cl[e] = run; }
            CWP[wq * 64 + lane] = run;
            __syncthreads();
            const float p0 = CWP[lane], p1 = CWP[64 + lane], p2 = CWP[128 + lane], p3 = CWP[192 + lane];
            const float cwC = (p0 + p1) + (p2 + p3);
            const float pre = (wq > 0 ? p0 : 0.f) + (wq > 1 ? p1 : 0.f) + (wq > 2 ? p2 : 0.f);
            if (ch + 1 < 64) {
#pragma unroll
                for (int x = 0; x < 5; ++x) *(LAS u32x4*)(gb + WK_RAW + x * 4096 + tg * 16) = raw[x]; }
            const float expC = __expf(cwC);
            float bh8[8], kh8[8], sq[8], bn[8]; float ePrev = __expf(pre);
#pragma unroll
            for (int e = 0; e < 8; ++e) { const float kkr = bf2f(k8[e]) * kkw; sq[e] = kkr * kkr; }
            const int ssw = __float_as_int(wave_sum8(sq, lane));
#pragma unroll
            for (int e = 0; e < 8; ++e) {
                const int s = 8 * wq + e; const float kf = bf2f(k8[e]), rf = bf2f(r8[e]), al = bf2f(a8[e]);
                const float kkr = kf * kkw; const float ss = __int_as_float(__builtin_amdgcn_readlane(ssw, bitrev3(e))); const float kk = kkr * rsqrt_fast(ss + 1e-12f);
                const float cw = pre + cl[e]; const float e1 = __expf(cw), e2 = __builtin_amdgcn_rcpf(e1), eC = expC * e2;
                const float kj = kf * (1.f + (al - 1.f) * kaw), kb = kk * al;
                *(LAS unsigned short*)(gb + WK_A + s * ST64 + lane * 2) = f2bf(-kk * ePrev); ePrev = e1;
                *(LAS unsigned short*)(gb + WK_R + s * ST64 + lane * 2) = f2bf(rf * e1);
                *(LAS unsigned short*)(gb + WK_B + s * ST64 + lane * 2) = f2bf(kb * e2);
                *(LAS unsigned short*)(gb + WK_K + s * ST64 + lane * 2) = f2bf(kj * e2);
                bh8[e] = kb * eC; kh8[e] = kj * eC;
                bn[e] = rf * kj * rkw;
            }
            { const float bsw = wave_sum8(bn, lane);
              if (lane < 8) { const int sg = seg * 2048 + ch * 32 + 8 * wq + (((lane & 1) << 2) | (lane & 2) | ((lane >> 2) & 1)), t = dir ? Tseq - 1 - sg : sg; bon[(seqbase + t) * 32] = bsw; } }
            { u32x4 w; w.x = cvt_pk_bf16(bh8[0], bh8[1]); w.y = cvt_pk_bf16(bh8[2], bh8[3]); w.z = cvt_pk_bf16(bh8[4], bh8[5]); w.w = cvt_pk_bf16(bh8[6], bh8[7]); *(LAS u32x4*)(gb + WK_BH + lane * ST32 + 16 * wq) = w;
              w.x = cvt_pk_bf16(kh8[0], kh8[1]); w.y = cvt_pk_bf16(kh8[2], kh8[3]); w.z = cvt_pk_bf16(kh8[4], kh8[5]); w.w = cvt_pk_bf16(kh8[6], kh8[7]); *(LAS u32x4*)(gb + WK_KH + lane * ST32 + 16 * wq) = w;
              w.x = (unsigned)v8[0] | ((unsigned)v8[1] << 16); w.y = (unsigned)v8[2] | ((unsigned)v8[3] << 16); w.z = (unsigned)v8[4] | ((unsigned)v8[5] << 16); w.w = (unsigned)v8[6] | ((unsigned)v8[7] << 16);
              *(LAS u32x4*)(gb + WK_VT + lane * ST32 + 16 * wq) = w; }
            if (wq == 0) WC[lane] = expC;
            if (ch + 2 < 64) WK_LOAD(ch + 2);
            __syncthreads();
            {
                const int mt = wq >> 1, nt = wq & 1;
                f32x4 ab = zero4, ak = zero4, rb = zero4, rk = zero4, abT = zero4;
                if (mt >= nt) {
                    const int arow = 16 * mt + l15, brow = 16 * nt + l15;
#pragma unroll
                    for (int ks = 0; ks < 2; ++ks) {
                        const bf16x8 af = frag_nat(gb + WK_A + arow * ST64 + 64 * ks + 16 * g), rf = frag_nat(gb + WK_R + arow * ST64 + 64 * ks + 16 * g);
                        const bf16x8 bf_ = frag_nat(gb + WK_B + brow * ST64 + 64 * ks + 16 * g), kf_ = frag_nat(gb + WK_K + brow * ST64 + 64 * ks + 16 * g);
                        ab = MFMA16(af, bf_, ab); ak = MFMA16(af, kf_, ak); rb = MFMA16(rf, bf_, rb); rk = MFMA16(rf, kf_, rk);
                        if (mt == nt) abT = MFMA16(bf_, af, abT);
                    }
                }
#pragma unroll
                for (int e = 0; e < 4; ++e) { const int s = 16 * mt + 4 * g + e, i = 16 * nt + l15; const bool lo = i < s, le = i <= s;
                    if (wq == 2) *(LAS unsigned short*)(gb + WK_A10 + (s - 16) * 32 + i * 2) = f2bf(ab[e]);
                    *(LAS unsigned short*)(gb + WK_AAK + s * ST32 + i * 2) = f2bf(lo ? ak[e] : 0.f);
                    *(LAS unsigned short*)(gb + WK_ARB + s * ST32 + i * 2) = f2bf(le ? rb[e] : 0.f);
                    *(LAS unsigned short*)(gb + WK_ARK + s * ST32 + i * 2) = f2bf(le ? rk[e] : 0.f); }
                if (mt == nt) {
                    f32x4 X, XT, PT;
#pragma unroll
                    for (int e = 0; e < 4; ++e) { const int rr = 4 * g + e; X[e] = l15 < rr ? ab[e] : 0.f; XT[e] = rr < l15 ? abT[e] : 0.f; PT[e] = XT[e] + (rr == l15 ? 1.f : 0.f); }
                    const bf16x8 xa = pack_acc(X, zero4), xt = pack_acc(XT, zero4);
                    const f32x4 X2 = MFMA16(xt, xa, zero4), X2T = MFMA16(xa, xt, zero4);
                    const bf16x8 x2 = pack_acc(X2, zero4), x2t = pack_acc(X2T, zero4);
                    PT = MFMA16(x2, pack_acc(PT, zero4), PT);
                    const f32x4 X4 = MFMA16(x2t, x2, zero4), X4T = MFMA16(x2, x2t, zero4);
                    const bf16x8 x4 = pack_acc(X4, zero4), x4t = pack_acc(X4T, zero4);
                    PT = MFMA16(x4, pack_acc(PT, zero4), PT);
                    const f32x4 X8 = MFMA16(x4t, x4, zero4);
                    PT = MFMA16(pack_acc(X8, zero4), pack_acc(PT, zero4), PT);
                    u32x2 w; w.x = cvt_pk_bf16(PT[0], PT[1]); w.y = cvt_pk_bf16(PT[2], PT[3]);
                    *(LAS u32x2*)(gb + WK_TT + (16 * mt + l15) * ST32 + (16 * mt + 4 * g) * 2) = w;
                }
            }
            __syncthreads();
            const bf16x8 vfr = frag_nat(gb + WK_VT + (16 * wq + l15) * ST32 + 16 * g);
            bf16x8 t00f, t11f, a10f;
            { const s16x4 q0 = *(const LAS s16x4*)(gb + WK_TT + l15 * ST32 + 8 * g), q1 = *(const LAS s16x4*)(gb + WK_TT + (16 + l15) * ST32 + (16 + 4 * g) * 2), q2 = *(const LAS s16x4*)(gb + WK_A10 + l15 * 32 + 8 * g);
              t00f = (bf16x8){q0[0], q0[1], q0[2], q0[3], 0, 0, 0, 0}; t11f = (bf16x8){q1[0], q1[1], q1[2], q1[3], 0, 0, 0, 0}; a10f = (bf16x8){q2[0], q2[1], q2[2], q2[3], 0, 0, 0, 0}; }
            if (MODE == 0) {
                bf16x8 sf[2]; sf[0] = pack_acc(st[0], st[1]); sf[1] = pack_acc(st[2], st[3]);
                f32x4 z[2], u[2], y[2];
#pragma unroll
                for (int mt = 0; mt < 2; ++mt) { const int row = 16 * mt + l15;
                    z[mt] = MFMA16(frag_perm(gb + WK_A + row * ST64 + 8 * g), sf[0], zero4); z[mt] = MFMA16(frag_perm(gb + WK_A + row * ST64 + 64 + 8 * g), sf[1], z[mt]);
                    z[mt] = MFMA16(frag_nat(gb + WK_AAK + row * ST32 + 16 * g), vfr, z[mt]); }
                u[0] = MFMA16(t00f, pack_acc(z[0], zero4), zero4);
                z[1] = MFMA16(a10f, pack_acc(u[0], zero4), z[1]);
                u[1] = MFMA16(t11f, pack_acc(z[1], zero4), zero4);
                const bf16x8 uf = pack_acc(u[0], u[1]);
#pragma unroll
                for (int mt = 0; mt < 2; ++mt) { const int row = 16 * mt + l15;
                    y[mt] = MFMA16(frag_perm(gb + WK_R + row * ST64 + 8 * g), sf[0], zero4); y[mt] = MFMA16(frag_perm(gb + WK_R + row * ST64 + 64 + 8 * g), sf[1], y[mt]);
                    y[mt] = MFMA16(frag_perm(gb + WK_ARB + row * ST32 + 8 * g), uf, y[mt]); y[mt] = MFMA16(frag_nat(gb + WK_ARK + row * ST32 + 16 * g), vfr, y[mt]); }
#pragma unroll
                for (int m = 0; m < 4; ++m) { const int crow = 16 * m + l15; const f32x4 wc4 = *(const LAS f32x4*)(WC + 16 * m + 4 * g);
                    st[m] = st[m] * wc4; st[m] = MFMA16(frag_perm(gb + WK_BH + crow * ST32 + 8 * g), uf, st[m]); st[m] = MFMA16(frag_nat(gb + WK_KH + crow * ST32 + 16 * g), vfr, st[m]); }
#pragma unroll
                for (int mt = 0; mt < 2; ++mt)
#pragma unroll
                    for (int e = 0; e < 4; ++e) { const int sg = seg * 2048 + ch * 32 + 16 * mt + 4 * g + e, t = dir ? Tseq - 1 - sg : sg;
                        yo[(seqbase + t) * D + hc + 16 * wq + l15] = f2bf(y[mt][e]); }
            } else {
                bf16x8 sf[2], sfi[2]; sf[0] = pack_acc(st[0], st[1]); sf[1] = pack_acc(st[2], st[3]); sfi[0] = pack_acc(sid[0], sid[1]); sfi[1] = pack_acc(sid[2], sid[3]);
                f32x4 z[2], zi[2], u[2], ui[2];
#pragma unroll
                for (int mt = 0; mt < 2; ++mt) { const int row = 16 * mt + l15; const bf16x8 a0 = frag_perm(gb + WK_A + row * ST64 + 8 * g), a1 = frag_perm(gb + WK_A + row * ST64 + 64 + 8 * g);
                    z[mt] = MFMA16(a0, sf[0], zero4); z[mt] = MFMA16(a1, sf[1], z[mt]); z[mt] = MFMA16(frag_nat(gb + WK_AAK + row * ST32 + 16 * g), vfr, z[mt]);
                    zi[mt] = MFMA16(a0, sfi[0], zero4); zi[mt] = MFMA16(a1, sfi[1], zi[mt]); }
                u[0] = MFMA16(t00f, pack_acc(z[0], zero4), zero4); ui[0] = MFMA16(t00f, pack_acc(zi[0], zero4), zero4);
                z[1] = MFMA16(a10f, pack_acc(u[0], zero4), z[1]); zi[1] = MFMA16(a10f, pack_acc(ui[0], zero4), zi[1]);
                u[1] = MFMA16(t11f, pack_acc(z[1], zero4), zero4); ui[1] = MFMA16(t11f, pack_acc(zi[1], zero4), zero4);
                const bf16x8 uf = pack_acc(u[0], u[1]), ufi = pack_acc(ui[0], ui[1]);
                __builtin_amdgcn_sched_barrier(0);
                bf16* mb = MB + ((size_t)task * 64 + ch) * 2048;
#pragma unroll
                for (int mt = 0; mt < 2; ++mt) { const int row = 16 * mt + l15; const bf16x8 r0 = frag_perm(gb + WK_R + row * ST64 + 8 * g), r1 = frag_perm(gb + WK_R + row * ST64 + 64 + 8 * g), rbf = frag_perm(gb + WK_ARB + row * ST32 + 8 * g);
                    f32x4 y = MFMA16(r0, sf[0], zero4); y = MFMA16(r1, sf[1], y); y = MFMA16(rbf, uf, y); y = MFMA16(frag_nat(gb + WK_ARK + row * ST32 + 16 * g), vfr, y);
                    f32x4 yi = MFMA16(r0, sfi[0], zero4); yi = MFMA16(r1, sfi[1], yi); yi = MFMA16(rbf, ufi, yi);
#pragma unroll
                    for (int e = 0; e < 4; ++e) { const int s = 16 * mt + 4 * g + e, sg = seg * 2048 + ch * 32 + s, t = dir ? Tseq - 1 - sg : sg;
                        yo[(seqbase + t) * D + hc + 16 * wq + l15] = f2bf(y[e]); mb[s * 64 + 16 * wq + l15] = f2bf(yi[e]); } }
                __builtin_amdgcn_sched_barrier(0);
#pragma unroll
                for (int m = 0; m < 4; ++m) { const int crow = 16 * m + l15; const f32x4 wc4 = *(const LAS f32x4*)(WC + 16 * m + 4 * g); const bf16x8 bhf = frag_perm(gb + WK_BH + crow * ST32 + 8 * g);
                    st[m] = st[m] * wc4; st[m] = MFMA16(bhf, uf, st[m]); st[m] = MFMA16(frag_nat(gb + WK_KH + crow * ST32 + 16 * g), vfr, st[m]);
                    sid[m] = sid[m] * wc4; sid[m] = MFMA16(bhf, ufi, sid[m]); }
            }
        }
#undef WK_LOAD
        if (MODE == 1 && seg < 7) {
            float* Pi = PT + (size_t)task * 8192; float* Th = Pi + 4096;
#pragma unroll
            for (int m = 0; m < 4; ++m)
#pragma unroll
                for (int e = 0; e < 4; ++e) { const int o = (16 * m + 4 * g + e) * 64 + 16 * wq + l15; Pi[o] = sid[m][e]; Th[o] = st[m][e]; }
        }
    }
}

DI void phase_wkv_fix(const Frame& F, const float* PT, const bf16* MB, bf16* Y) {
    const int lane = F.lane, l15 = lane & 15, g = lane >> 4, wq = F.wave & 3, grp = F.wave >> 2;
    const int Tseq = S;
    const f32x4 zero4 = (f32x4){0.f, 0.f, 0.f, 0.f};
    for (int task = F.vcu * 2 + grp; task < 512; task += F.G * 2) {
        const int chain = task >> 3, head = chain >> 1, dir = chain & 1, seg = task & 7;
        if (seg == 0) continue;
        f32x4 st[4];
#pragma unroll
        for (int m = 0; m < 4; ++m) st[m] = zero4;
        for (int j = 0; j < seg; ++j) {
            const float* Pi = PT + (size_t)((task & ~7) + j) * 8192; const float* Th = Pi + 4096;
            bf16x8 sf[2]; sf[0] = pack_acc(st[0], st[1]); sf[1] = pack_acc(st[2], st[3]);
#pragma unroll
            for (int m = 0; m < 4; ++m) { f32x4 nw;
#pragma unroll
                for (int e = 0; e < 4; ++e) nw[e] = Th[(16 * m + 4 * g + e) * 64 + 16 * wq + l15];
#pragma unroll
                for (int ks = 0; ks < 2; ++ks) { const float* pr = Pi + (16 * m + l15) * 64 + 32 * ks + 4 * g; const f32x4 lo = *(const f32x4*)pr, hi = *(const f32x4*)(pr + 16);
                    nw = MFMA16(pack_acc(lo, hi), sf[ks], nw); }
                st[m] = nw; }
        }
        bf16x8 sf[2]; sf[0] = pack_acc(st[0], st[1]); sf[1] = pack_acc(st[2], st[3]);
        bf16* yo = Y + (size_t)dir * SLOT_ELEMS; const int hc = head * 64;
        u32x2 mlo[2][2][2], mhi[2][2][2]; unsigned short yv[2][2][4];
#define FIX_LOAD(c_) do { _Pragma("unroll") for (int q = 0; q < 2; ++q) { const bf16* mb = MB + ((size_t)task * 64 + (c_) + q) * 2048; \
            _Pragma("unroll") for (int mt = 0; mt < 2; ++mt) { const bf16* mr = mb + (16 * mt + l15) * 64 + 4 * g; \
                _Pragma("unroll") for (int ks = 0; ks < 2; ++ks) { mlo[q][mt][ks] = *(const u32x2*)(mr + 32 * ks); mhi[q][mt][ks] = *(const u32x2*)(mr + 32 * ks + 16); } \
                _Pragma("unroll") for (int e = 0; e < 4; ++e) { const int sg = seg * 2048 + ((c_) + q) * 32 + 16 * mt + 4 * g + e, t = dir ? Tseq - 1 - sg : sg; yv[q][mt][e] = yo[(size_t)t * D + hc + 16 * wq + l15]; } } } } while (0)
        FIX_LOAD(0);
#pragma unroll 1
        for (int c2 = 0; c2 < 64; c2 += 2) {
            f32x4 acc[2][2]; float yf[2][2][4];
#pragma unroll
            for (int q = 0; q < 2; ++q)
#pragma unroll
                for (int mt = 0; mt < 2; ++mt) { acc[q][mt] = zero4;
#pragma unroll
                    for (int ks = 0; ks < 2; ++ks) { const u32x4 w = (u32x4){mlo[q][mt][ks].x, mlo[q][mt][ks].y, mhi[q][mt][ks].x, mhi[q][mt][ks].y}; acc[q][mt] = MFMA16(__builtin_bit_cast(bf16x8, w), sf[ks], acc[q][mt]); }
#pragma unroll
                    for (int e = 0; e < 4; ++e) yf[q][mt][e] = bf2f(yv[q][mt][e]); }
            if (c2 + 2 < 64) FIX_LOAD(c2 + 2);
#pragma unroll
            for (int q = 0; q < 2; ++q)
#pragma unroll
                for (int mt = 0; mt < 2; ++mt)
#pragma unroll
                    for (int e = 0; e < 4; ++e) { const int sg = seg * 2048 + (c2 + q) * 32 + 16 * mt + 4 * g + e, t = dir ? Tseq - 1 - sg : sg; yo[(size_t)t * D + hc + 16 * wq + l15] = f2bf(yf[q][mt][e] + acc[q][mt][e]); }
        }
#undef FIX_LOAD
    }
}
DI unsigned v_off(unsigned row, unsigned ch) { return 256u * row + 16u * (ch ^ (((row & 3u) << 2) | ((row >> 2) & 3u))); }
DI bf16x8 tr_read2(unsigned a0, unsigned a1) {
    s16x4 lo, hi; asm volatile("ds_read_b64_tr_b16 %0, %2\n\tds_read_b64_tr_b16 %1, %3\n\ts_waitcnt lgkmcnt(0)" : "=&v"(lo), "=&v"(hi) : "v"(a0), "v"(a1) : "memory");
    return (bf16x8){lo[0], lo[1], lo[2], lo[3], hi[0], hi[1], hi[2], hi[3]};
}
constexpr int ATT_RING = 65536;
DI void tr_read4_nw(unsigned alo, unsigned ahi, s16x4 (&lo)[2], s16x4 (&hi)[2]) {
    asm volatile("ds_read_b64_tr_b16 %0, %4\n\tds_read_b64_tr_b16 %2, %5\n\tds_read_b64_tr_b16 %1, %4 offset:8192\n\tds_read_b64_tr_b16 %3, %5 offset:8192"
                 : "=&v"(lo[0]), "=&v"(lo[1]), "=&v"(hi[0]), "=&v"(hi[1]) : "v"(alo), "v"(ahi) : "memory");
}
DI void tr_wait12(s16x4 (&a)[2], s16x4 (&b)[2], s16x4 (&c)[2], s16x4 (&d)[2], s16x4 (&e)[2], s16x4 (&f)[2]) {
    asm volatile("s_waitcnt lgkmcnt(0)" : "+v"(a[0]), "+v"(a[1]), "+v"(b[0]), "+v"(b[1]), "+v"(c[0]), "+v"(c[1]), "+v"(d[0]), "+v"(d[1]), "+v"(e[0]), "+v"(e[1]), "+v"(f[0]), "+v"(f[1]) :: "memory");
}
struct AU { int gi, dil, NT, cls, up, run; size_t seqbase; };
DI AU au_decode(int k, int part, int Tseq) {
    AU a; a.gi = k >> 3; const int idx = 8 * part + (k & 7); a.dil = a.gi == 0 ? 1 : (a.gi == 1 ? 4 : 16); const int L = Tseq / a.dil; a.NT = L >> 6; const int upr = L >> 7;
    a.run = idx / upr; a.up = idx - a.run * upr; const int seq = a.run / a.dil; a.cls = a.run - seq * a.dil; a.seqbase = (size_t)seq * Tseq; return a;
}
DI void att_tiles_load(const bf16* QKV, const AU& a, int head, int t0, int tid, u32x4 (&kr)[4], u32x4 (&vr)[4]) {
    const int kcol = a.gi * 6144 + 2048 + head * 128;
#pragma unroll
    for (int i = 0; i < 4; ++i) { const int id = tid + 512 * i, tl = id >> 10, rem = id & 1023, r = rem >> 4, ch = rem & 15; int t = t0 + tl; t = t < 0 ? 0 : (t >= a.NT ? a.NT - 1 : t);
        const bf16* p = QKV + (a.seqbase + (size_t)(64 * t + r) * a.dil + a.cls) * NQKV + kcol + 8 * ch; kr[i] = *(const u32x4*)p; vr[i] = *(const u32x4*)(p + 2048); }
}
DI void att_tiles_store(LAS unsigned char* ring, int t0, int tid, const u32x4 (&kr)[4], const u32x4 (&vr)[4]) {
#pragma unroll
    for (int i = 0; i < 4; ++i) { const int id = tid + 512 * i, tl = id >> 10, rem = id & 1023, r = rem >> 4, ch = rem & 15; const unsigned o = v_off((unsigned)(((t0 + tl) & 3) * 64 + r), ch);
        *(LAS u32x4*)(ring + o) = kr[i]; *(LAS u32x4*)(ring + ATT_RING + o) = vr[i]; }
}
DI void phase_attn(const Frame& F, const bf16* QKV, int Tseq, const float* biastab, bf16* OG, float* LSE, const int gsel) {
    const int lane = F.lane, l15 = lane & 15, g = lane >> 4, blk = F.wave >> 2, wq = F.wave & 3, tid = F.tid;
    constexpr float LOG2E = 1.4426950408889634f, SCALE = 0.08838834764831845f * LOG2E;
    LAS unsigned char* ring = F.lds;
    const unsigned vbase = (unsigned)(uintptr_t)(F.ldsg + ATT_RING);
    const int qi = 16 * wq + l15;
    for (int vw = F.vcu; vw < 256; vw += F.G) {
        const int head = vw & 15, part = vw >> 4;
        unsigned biasp[6][2][2]; int gi_cur = -1;
        u32x4 kb[4], vb[4];
        { const AU a0 = au_decode(8 * gsel, part, Tseq); att_tiles_load(QKV, a0, head, 2 * a0.up - 1, tid, kb, vb); }
        int pgi = -1, prun = -1, pup = -9;
#pragma unroll 1
        for (int kk = 0; kk < 8; ++kk) { int gs_ = gsel; asm volatile("" : "+s"(gs_)); const int k = 8 * gs_ + kk;
            const AU a = au_decode(k, part, Tseq);
            if (a.gi != gi_cur) { gi_cur = a.gi; const float* bt = biastab + (a.gi * 16 + head) * 129;
#pragma unroll
                for (int ks = 0; ks < 6; ++ks)
#pragma unroll
                    for (int tau = 0; tau < 2; ++tau)
#pragma unroll
                        for (int e2 = 0; e2 < 2; ++e2) { int o0 = 32 * ks + 8 * g + 4 * tau + 2 * e2 - qi, o1 = o0 + 1; o0 = o0 < 0 ? 0 : (o0 > 128 ? 128 : o0); o1 = o1 < 0 ? 0 : (o1 > 128 ? 128 : o1);
                            biasp[ks][tau][e2] = cvt_pk_bf16(bt[o0] * LOG2E, bt[o1] * LOG2E); } }
            const bool cont = (a.gi == pgi) && (a.run == prun) && (a.up == pup + 1);
            pgi = a.gi; prun = a.run; pup = a.up;
            const int n = 2 * a.up + blk;
            const size_t tq = a.seqbase + (size_t)(64 * n + qi) * a.dil + a.cls; const int qcol = a.gi * 6144 + head * 128;
            bf16x8 qf[4];
#pragma unroll
            for (int s = 0; s < 4; ++s) qf[s] = *(const bf16x8*)(QKV + tq * NQKV + qcol + 32 * s + 8 * g);
            __syncthreads();
            if (!cont) { att_tiles_store(ring, 2 * a.up - 1, tid, kb, vb); att_tiles_load(QKV, a, head, 2 * a.up + 1, tid, kb, vb); }
            att_tiles_store(ring, 2 * a.up + 1, tid, kb, vb);
            __syncthreads();
            f32x4 sc[6][2];
#pragma unroll
            for (int ks = 0; ks < 6; ++ks) {
                const unsigned rbase = (unsigned)(((n - 1 + (ks >> 1)) & 3) * 64 + 32 * (ks & 1));
#pragma unroll
                for (int tau = 0; tau < 2; ++tau) {
                    const unsigned row = rbase + 8 * (l15 >> 2) + 4 * tau + (l15 & 3);
                    f32x4 acc = (f32x4){0.f, 0.f, 0.f, 0.f};
#pragma unroll
                    for (int s = 0; s < 4; ++s) { const bf16x8 kf = *(const LAS bf16x8*)(ring + v_off(row, 4 * s + g)); acc = __builtin_amdgcn_mfma_f32_16x16x32_bf16(kf, qf[s], acc, 0, 0, 0); }
                    sc[ks][tau] = acc;
                }
                if (ks & 1) __builtin_amdgcn_sched_barrier(0);
            }
            const bool first = (n == 0), last = (n == a.NT - 1);
            float mx = -1e30f;
#pragma unroll
            for (int ks = 0; ks < 6; ++ks)
#pragma unroll
                for (int tau = 0; tau < 2; ++tau)
#pragma unroll
                    for (int e = 0; e < 4; ++e) { const int j = 32 * ks + 8 * g + 4 * tau + e;
                        const bool ok = ks < 2 ? (j >= qi && !first) : (ks >= 4 ? (j - 128 <= qi && !last) : true);
                        const unsigned bw = biasp[ks][tau][e >> 1]; const float bv = (e & 1) ? bfhi(bw) : bflo(bw);
                        const float lg = ok ? sc[ks][tau][e] * SCALE + bv : -1e30f; sc[ks][tau][e] = lg; mx = fmaxf(mx, lg); }
            mx = rows_max(mx);
            float sum = 0.f; bf16x8 pf[6];
#pragma unroll
            for (int ks = 0; ks < 6; ++ks) { float p[8];
#pragma unroll
                for (int tau = 0; tau < 2; ++tau)
#pragma unroll
                    for (int e = 0; e < 4; ++e) { const float pe = __builtin_amdgcn_exp2f(sc[ks][tau][e] - mx); p[4 * tau + e] = pe; sum += pe; }
                u32x4 w; w.x = cvt_pk_bf16(p[0], p[1]); w.y = cvt_pk_bf16(p[2], p[3]); w.z = cvt_pk_bf16(p[4], p[5]); w.w = cvt_pk_bf16(p[6], p[7]); pf[ks] = __builtin_bit_cast(bf16x8, w); }
            sum = rows_sum(sum);
            const float inv = __builtin_amdgcn_rcpf(sum);
            if (kk + 1 < 8) { const AU nx = au_decode(k + 1, part, Tseq); const bool ncont = (nx.gi == a.gi) && (nx.run == a.run) && (nx.up == a.up + 1);
                att_tiles_load(QKV, nx, head, ncont ? 2 * nx.up + 1 : 2 * nx.up - 1, tid, kb, vb); }
            const unsigned q4 = (unsigned)l15 >> 2, pp = (unsigned)lane & 3u;
            const unsigned s0 = (unsigned)((n - 1) & 3) * 16384u, s1 = (unsigned)(n & 3) * 16384u, s2 = (unsigned)((n + 1) & 3) * 16384u;
            bf16* orow = OG + (size_t)a.gi * SLOT_ELEMS + tq * D + head * 128 + 4 * g;
#pragma unroll
            for (int c = 0; c < 8; ++c) {
                const unsigned r0 = 8u * g + q4, ch = 2u * c + (pp >> 1);
                const unsigned alo = vbase + v_off(r0, ch) + 8u * (pp & 1u), ahi = vbase + v_off(r0 + 4u, ch) + 8u * (pp & 1u);
                s16x4 l0[2], h0[2], l1[2], h1[2], l2[2], h2[2];
                tr_read4_nw(alo + s0, ahi + s0, l0, h0); tr_read4_nw(alo + s1, ahi + s1, l1, h1); tr_read4_nw(alo + s2, ahi + s2, l2, h2);
                tr_wait12(l0, h0, l1, h1, l2, h2);
                f32x4 oa = (f32x4){0.f, 0.f, 0.f, 0.f};
#define ATT_PV(L_, H_, KS_) oa = __builtin_amdgcn_mfma_f32_16x16x32_bf16((bf16x8){L_[0], L_[1], L_[2], L_[3], H_[0], H_[1], H_[2], H_[3]}, pf[KS_], oa, 0, 0, 0)
                ATT_PV(l0[0], h0[0], 0); ATT_PV(l0[1], h0[1], 1); ATT_PV(l1[0], h1[0], 2); ATT_PV(l1[1], h1[1], 3); ATT_PV(l2[0], h2[0], 4); ATT_PV(l2[1], h2[1], 5);
#undef ATT_PV
                u32x2 w; w.x = cvt_pk_bf16(oa[0] * inv, oa[1] * inv); w.y = cvt_pk_bf16(oa[2] * inv, oa[3] * inv);
                *(u32x2*)(orow + 16 * c) = w; }
            if (g == 0) LSE[(size_t)a.gi * S * 16 + tq * 16 + head] = (mx + __builtin_amdgcn_logf(sum)) * 0.6931471805599453f;
        }
    }
}
DI void phase_attn_combine(const Frame& F, const bf16* OG, const float* LSE, unsigned char* out, float* asc) {
    for (int row = F.gw; row < S; row += F.NGW) {
        float o[4][8]; float mx = 0.f;
#pragma unroll
        for (int jj = 0; jj < 4; ++jj) {
            const int c0 = 512 * jj + 8 * F.lane, head = c0 >> 7; const size_t e0 = (size_t)row * D + c0;
            const float l0 = LSE[(size_t)row * 16 + head], l1 = LSE[(size_t)S * 16 + (size_t)row * 16 + head], l2 = LSE[(size_t)2 * S * 16 + (size_t)row * 16 + head];
            const float m = fmaxf(l0, fmaxf(l1, l2)); float w0 = __expf(l0 - m), w1 = __expf(l1 - m), w2 = __expf(l2 - m); const float inv = 1.f / (w0 + w1 + w2); w0 *= inv; w1 *= inv; w2 *= inv;
            float a[8], b[8], c[8];
            unpack8(*(const u32x4*)(OG + e0), a); unpack8(*(const u32x4*)(OG + SLOT_ELEMS + e0), b); unpack8(*(const u32x4*)(OG + 2 * SLOT_ELEMS + e0), c);
#pragma unroll
            for (int e = 0; e < 8; ++e) { o[jj][e] = w0 * a[e] + w1 * b[e] + w2 * c[e]; mx = fmaxf(mx, fabsf(o[jj][e])); }
        }
        mx = wave_max(mx); const float qi = mx > 0.f ? 127.f / mx : 0.f;
#pragma unroll
        for (int jj = 0; jj < 4; ++jj) { u32x2 w; w.x = pack4_i8(o[jj][0] * qi, o[jj][1] * qi, o[jj][2] * qi, o[jj][3] * qi); w.y = pack4_i8(o[jj][4] * qi, o[jj][5] * qi, o[jj][6] * qi, o[jj][7] * qi);
            *(u32x2*)(out + (size_t)row * D + 512 * jj + 8 * F.lane) = w; }
        if (F.lane == 0) asc[row] = mx * (1.f / 127.f);
    }
}
constexpr int QPL = 16;
#ifndef PG_ALIGN
#define PG_ALIGN true
#endif
#ifndef PG_SP2
#define PG_SP2 true
#endif
__global__ void __launch_bounds__(NWAVES * 64, 2) fwd_kernel(Args a_unused) {
    extern __shared__ __attribute__((aligned(16))) unsigned char lds[];
#define MKFRAME() Frame F; { int tid_; asm volatile("v_mbcnt_lo_u32_b32 %0, -1, 0\n\tv_mbcnt_hi_u32_b32 %0, -1, %0" : "=v"(tid_)); tid_ += wave_s * 64;     int bx_ = blockIdx.x, g_ = gridDim.x; asm volatile("" : "+s"(bx_), "+s"(g_)); \
        F.lds = (LAS unsigned char*)lds; F.ldsg = lds; F.tid = tid_; F.lane = tid_ & 63; F.wave = __builtin_amdgcn_readfirstlane(tid_ >> 6); \
        F.G = g_; F.vcu = (g_ % 8 == 0) ? (bx_ % 8) * (g_ / 8) + bx_ / 8 : bx_; F.gw = F.vcu * NWAVES + F.wave; F.NGW = g_ * NWAVES; }
    const int wave_s = __builtin_amdgcn_readfirstlane((int)threadIdx.x >> 6);
    volatile LAS unsigned* MISC = (volatile LAS unsigned*)((LAS unsigned char*)lds + MISC_OFF);
    for (int u = threadIdx.x; u < (LDS_BYTES - LDSCTL_OFF) / 4; u += NWAVES * 64) ((LAS unsigned*)((LAS unsigned char*)lds + LDSCTL_OFF))[u] = 0u;
    __syncthreads();
    int slab_lo, slab_hi, ph_lo, ph_hi, use_bar, do_pro;
    XcdBarrier bar;
    { ArgsP ap = args_ptr(); slab_lo = ap->slab_lo; slab_hi = ap->slab_hi; ph_lo = ap->ph_lo; ph_hi = ap->ph_hi; use_bar = ap->use_bar; do_pro = ap->do_pro;
      bar.bar = (unsigned*)(ap->ws + WS_CTL) + CW_BAR; bar.x = 0; bar.st = nullptr; bar.w = wave_s;
      if (use_bar) { bar = xcd_barrier_post((unsigned*)(ap->ws + WS_CTL) + CW_BAR, MISC + 8); bar.w = wave_s; } }
#define SEAM() do { if (use_bar) xcd_barrier(bar); } while (0)
#define SLOT(i) ((bf16*)(ws + WS_SLOT) + (size_t)(i) * SLOT_ELEMS)
#define LDA() MKFRAME(); ArgsP ap = args_ptr(); unsigned char* ws = ap->ws; (void)ws; const int c_ord = (int)blockIdx.x; (void)c_ord

    if (do_pro & 1) { MKFRAME(); p0_scales(F); SEAM(); }
    if (do_pro & 2) { MKFRAME(); p0_prologue(F); SEAM(); }

    for (int slab = slab_lo; slab < slab_hi; ++slab) {
        const int nseq = slab < 2 ? 8 : 1, Tseq = S / nseq;
#pragma unroll 1
        for (int layer = 0; layer < 2; ++layer) {
            const int step0 = (slab * 2 + layer) * QPL;
#if MK_ONE_LAUNCH
#define RUN(q) true
#else
#define RUN(q) (ph_lo <= step0 + (q) && step0 + (q) < ph_hi)
#endif
#define XIN ((slab < 2 ? ap->in[0] : ap->in[1]) + (size_t)(slab & 1) * S * D)
#define XOUT (ap->out + (size_t)slab * S * D)
#define XBF ((bf16*)XOUT + (size_t)S * D)
#define GAINS (ap->in[4] + (size_t)layer * 4 * D)
#define PIN ((slab < 2 ? ap->in[2] : ap->in[3]) + ((size_t)layer * 2 * S + (size_t)(slab & 1) * S) * PLE)
            if (layer == 0) {
                if (RUN(0)) { LDA(); phase_mix(F, XIN, Tseq, GAINS, ap->in[6], SLOT(0)); SEAM(); }
                if (RUN(1)) { LDA();
                    pg8::Gemm g{SLOT(0), (const bf16*)(ws + WS_WB0), D}; pg8::MultiOrder<pg8::TabL0B> O{F.G, c_ord};
                    pg8::EpiL0B E{SLOT(6), (bf16*)(ws + WS_HL)};
                    pg8::gemm_phase<pg8::EpiL0B, pg8::MultiOrder<pg8::TabL0B>, PG_ALIGN, PG_SP2>(F.lds, g, O, E, F.tid); SEAM(); }
                if (RUN(2)) { LDA();
                    pg8::Gemm g{(const bf16*)(ws + WS_HL), (const bf16*)(ws + WS_WL2), 256}; pg8::MultiOrder<pg8::TabL0C> O{F.G, c_ord};
                    pg8::EpiL0C E{SLOT(0), ap->in[8], ap->in[11]};
                    pg8::gemm_phase<pg8::EpiL0C, pg8::MultiOrder<pg8::TabL0C>, PG_ALIGN, PG_SP2>(F.lds, g, O, E, F.tid); SEAM(); }
                if (RUN(3) && nseq == 1) { LDA(); phase_wkv<1>(F, nseq, SLOT(6), SLOT(7), SLOT(8), SLOT(0), ap->in[16], ap->in[17], ap->in[18], SLOT(9), (float*)(ws + WS_PT), SLOT(11), (float*)(ws + WS_PB)); SEAM(); }
                if (RUN(4)) { LDA(); if (nseq == 1) phase_wkv_fix(F, (const float*)(ws + WS_PT), SLOT(11), SLOT(9)); else phase_wkv<0>(F, nseq, SLOT(6), SLOT(7), SLOT(8), SLOT(0), ap->in[16], ap->in[17], ap->in[18], SLOT(9), (float*)(ws + WS_PT), nullptr, (float*)(ws + WS_PB)); SEAM(); }
                if (RUN(5)) { LDA(); phase_post(F, SLOT(9), SLOT(10), SLOT(8), SLOT(4), (const float*)(ws + WS_PB), ap->in[19], ap->in[20], SLOT(5)); SEAM(); }
            } else {
                if (RUN(0)) { LDA(); phase_resnorm<false, false>(F, XBF, nullptr, nullptr, nullptr, GAINS, (unsigned char*)SLOT(0), (float*)(ws + WS_ASC), nullptr, nullptr); SEAM(); }
#pragma unroll 1
                for (int gi = 0; gi < 3; ++gi) {
                    if (RUN(1 + 2 * gi)) { LDA();
                        pg8::Gemm g{SLOT(0), (const bf16*)(ws + WS_WQKV) + (size_t)gi * 6144 * (D / 2), D / 2}; pg8::MultiOrder<pg8::TabOne<24>> O{F.G, c_ord};
                        pg8::EpiPlainI8 E{SLOT(1) + gi * 6144, NQKV, (const float*)(ws + WS_ASC), (const float*)(ws + WS_WSC) + WSC_QKV + gi * 6144};
                        pg8::gemm_phase<pg8::EpiPlainI8, pg8::MultiOrder<pg8::TabOne<24>>, PG_ALIGN, PG_SP2>(F.lds, g, O, E, F.tid); SEAM(); }
                    if (RUN(2 + 2 * gi)) { LDA(); phase_attn(F, SLOT(1), Tseq, (const float*)(ws + WS_BIAS), SLOT(10), (float*)(ws + WS_LSE), gi); SEAM(); }
                }
                if (RUN(7)) { LDA(); phase_attn_combine(F, SLOT(10), (const float*)(ws + WS_LSE), (unsigned char*)SLOT(0), (float*)(ws + WS_ASC)); SEAM(); }
                if (RUN(8)) { LDA();
                    pg8::Gemm g{SLOT(0), (const bf16*)(ws + WS_WO1), D / 2}; pg8::MultiOrder<pg8::TabOne<8>> O{F.G, c_ord};
                    pg8::EpiPlainI8 E{SLOT(1), D, (const float*)(ws + WS_ASC), (const float*)(ws + WS_WSC) + WSC_WO + D};
                    pg8::gemm_phase<pg8::EpiPlainI8, pg8::MultiOrder<pg8::TabOne<8>>, PG_ALIGN, PG_SP2>(F.lds, g, O, E, F.tid); SEAM(); }
            }
            const int sA = layer ? 0 : 5, sB = layer ? 1 : 0, sC = layer ? 2 : 1, sD = layer ? 3 : 2, sE = layer ? 6 : 5;
            if (RUN(9) && layer == 0) { LDA();
                pg8::Gemm g{SLOT(sA), (const bf16*)(ws + WS_WO0), D}; pg8::MultiOrder<pg8::TabOne<8>> O{F.G, c_ord};
                pg8::EpiPlain E{SLOT(sB), D};
                pg8::gemm_phase<pg8::EpiPlain, pg8::MultiOrder<pg8::TabOne<8>>, PG_ALIGN, PG_SP2>(F.lds, g, O, E, F.tid); SEAM(); }
            if (RUN(10)) { LDA(); if (layer == 0) phase_resnorm<true, true>(F, XIN, XBF, SLOT(sB), GAINS + D, GAINS + 2 * D, (unsigned char*)SLOT(sC), (float*)(ws + WS_ASC), PIN, (bf16*)(ws + WS_PB));
                else phase_resnorm<true, false>(F, XBF, XBF, SLOT(sB), GAINS + D, GAINS + 2 * D, (unsigned char*)SLOT(sC), (float*)(ws + WS_ASC), PIN, (bf16*)(ws + WS_PB)); SEAM(); }
            if (RUN(11)) { LDA();
                pg8::Gemm g{SLOT(sC), (const bf16*)(ws + WS_WGU) + (size_t)layer * FF * D, D / 2}; pg8::MultiOrder<pg8::TabOne<44>> O{F.G, c_ord};
                pg8::EpiSwiGLUI8 E{SLOT(sD), (const float*)(ws + WS_ASC), (const float*)(ws + WS_WSC) + WSC_GU + layer * 2 * FF};
                pg8::gemm_phase<pg8::EpiSwiGLUI8, pg8::MultiOrder<pg8::TabOne<44>>, PG_ALIGN, PG_SP2>(F.lds, g, O, E, F.tid); SEAM(); }
            if (RUN(14)) { LDA(); phase_quant_hidden(F, SLOT(sD), (unsigned char*)SLOT(10), (float*)(ws + WS_ASC)); SEAM(); }
            if (RUN(12)) { LDA();
                { pg8::Gemm g{SLOT(10), (const bf16*)(ws + WS_WDN) + (size_t)layer * D * FF, FF / 2}; pg8::MultiOrder<pg8::TabOne<8>> O{F.G, c_ord};
                  pg8::EpiPlainI8 E{SLOT(sB), D, (const float*)(ws + WS_ASC), (const float*)(ws + WS_WSC) + WSC_DN + (layer ? 0 : 2048)};
                  pg8::gemm_phase<pg8::EpiPlainI8, pg8::MultiOrder<pg8::TabOne<8>>, PG_ALIGN, PG_SP2>(F.lds, g, O, E, F.tid); }
                { pg8::Gemm g{(const bf16*)(ws + WS_PB), (const bf16*)(ws + WS_WPP) + (size_t)layer * D * PLE, PLE}; pg8::MultiOrder<pg8::TabOne<8>> O{F.G, c_ord};
                  pg8::EpiPlain E{SLOT(sE), D};
                  pg8::gemm_phase<pg8::EpiPlain, pg8::MultiOrder<pg8::TabOne<8>>, PG_ALIGN, PG_SP2>(F.lds, g, O, E, F.tid); }
                SEAM(); }
            if (RUN(13)) { LDA(); phase_resnorm<true, false>(F, XBF, layer ? SLOT(7) : XBF, SLOT(sB), GAINS + 3 * D, ap->in[26] + (size_t)layer * D, (unsigned char*)SLOT(sC), (float*)(ws + WS_ASC), nullptr, nullptr); SEAM(); }
            if (RUN(15)) { LDA();
                pg8::Gemm g{SLOT(sC), (const bf16*)(ws + WS_WPG) + (size_t)layer * D * D / 2, D / 2}; pg8::MultiOrder<pg8::TabOne<8>> O{F.G, c_ord};
                pg8::EpiPleGateI8 E{layer ? SLOT(7) : XBF, XBF, layer ? XOUT : nullptr, SLOT(sE), (const float*)(ws + WS_ASC), (const float*)(ws + WS_WSC) + WSC_PG + layer * D};
                pg8::gemm_phase<pg8::EpiPleGateI8, pg8::MultiOrder<pg8::TabOne<8>>, PG_ALIGN, PG_SP2>(F.lds, g, O, E, F.tid); SEAM(); }
#undef RUN
        }
    }
}

extern "C" void kernel_launch(void* const* d_in, const int* in_sizes, int n_in, void* d_out, int out_size, void* d_ws, size_t ws_size, hipStream_t stream) {
    static int grid = 0;
    if (grid == 0) {
        if (n_in != 29 || ws_size < WS_END) { fprintf(stderr, "kernel_launch: unexpected inputs (n_in %d, ws %zu)\n", n_in, ws_size); grid = -1; return; }
        int dev = 0, cus = 0, per_cu = 0;
        if (hipGetDevice(&dev) != hipSuccess || hipDeviceGetAttribute(&cus, hipDeviceAttributeMultiprocessorCount, dev) != hipSuccess) { grid = -1; return; }
        if (hipFuncSetAttribute((const void*)fwd_kernel, hipFuncAttributeMaxDynamicSharedMemorySize, LDS_BYTES) != hipSuccess) { fprintf(stderr, "kernel_launch: hipFuncSetAttribute failed\n"); grid = -1; return; }
        if (hipOccupancyMaxActiveBlocksPerMultiprocessor(&per_cu, (const void*)fwd_kernel, NWAVES * 64, LDS_BYTES) != hipSuccess || per_cu < 1) fprintf(stderr, "kernel_launch: occupancy query says %d\n", per_cu);
        (void)hipGetLastError();
        grid = cus;
    }
    if (grid < 0) return;
    (void)hipMemsetAsync((char*)d_ws + WS_CTL, 0, CTL_BYTES, stream);
    Args a{};
    for (int i = 0; i < 29; ++i) a.in[i] = (const float*)d_in[i];
    a.out = (float*)d_out; a.ws = (unsigned char*)d_ws;
#if MK_ONE_LAUNCH
    a.slab_lo = 0; a.slab_hi = NSLAB; a.ph_lo = 0; a.ph_hi = NSLAB * 2 * QPL; a.use_bar = 1; a.do_pro = 3;
    hipLaunchKernelGGL(fwd_kernel, dim3(grid), dim3(NWAVES * 64), LDS_BYTES, stream, a);
#else
    a.use_bar = 0;
    a.slab_lo = 0; a.slab_hi = 0; a.ph_lo = 0; a.ph_hi = 0; a.do_pro = 1;
    hipLaunchKernelGGL(fwd_kernel, dim3(grid), dim3(NWAVES * 64), LDS_BYTES, stream, a);
    a.do_pro = 2;
    hipLaunchKernelGGL(fwd_kernel, dim3(grid), dim3(NWAVES * 64), LDS_BYTES, stream, a);
    a.do_pro = 0;
    for (int slab = 0; slab < NSLAB; ++slab)
        for (int layer = 0; layer < 2; ++layer)
            for (int q = 0; q < QPL; ++q) {
                if ((layer == 0 ? ((q == 3 && slab < 2) || (q >= 6 && q <= 8)) : (q == 9)) || q == 14) continue;
                a.slab_lo = slab; a.slab_hi = slab + 1; a.ph_lo = (slab * 2 + layer) * QPL + q; a.ph_hi = a.ph_lo + 1;
                hipLaunchKernelGGL(fwd_kernel, dim3(grid), dim3(NWAVES * 64), LDS_BYTES, stream, a);
            }
#endif
}
```

```cpp
#include <hip/hip_runtime.h>
#include <cstdio>
#include <cstdint>

#define GAS __attribute__((address_space(1)))
#define LAS __attribute__((address_space(3)))
#define DI __device__ __forceinline__
typedef unsigned short bf16;
typedef short bf16x8 __attribute__((ext_vector_type(8)));
typedef short s16x4 __attribute__((ext_vector_type(4)));
typedef float f32x4 __attribute__((ext_vector_type(4)));
typedef float f32x2 __attribute__((ext_vector_type(2)));
typedef unsigned u32x4 __attribute__((ext_vector_type(4)));
typedef unsigned u32x2 __attribute__((ext_vector_type(2)));

constexpr int D = 2048, FF = 5632, NQKV = 18432, PLE = 256;
constexpr int S = 16384;
constexpr int NSLAB = 4;
constexpr int NPANEL = S / 256;
constexpr float NORM_EPS = 1e-6f, GN_EPS = 64e-5f;

constexpr size_t MiB = 1u << 20;
constexpr size_t WS_CTL = 0, CTL_BYTES = 1 * MiB;
constexpr size_t WS_BIAS = 1 * MiB;
constexpr size_t WS_WSC = 1 * MiB + 64 * 1024;
constexpr int WSC_QKV = 0, WSC_GU = 18432, WSC_PG = 18432 + 2 * 11264, WSC_WO = WSC_PG + 2 * 2048, WSC_DN = WSC_WO + 2 * 2048  ;
constexpr size_t WS_WB0 = 2 * MiB;
constexpr size_t WS_WL2 = 29 * MiB;
constexpr size_t WS_WO0 = 34 * MiB;
constexpr size_t WS_WQKV = 42 * MiB;
constexpr size_t WS_WO1 = 114 * MiB;
constexpr size_t WS_WGU = 122 * MiB;
constexpr size_t WS_WDN = 210 * MiB;
constexpr size_t WS_WPG = 254 * MiB;
constexpr size_t WS_WPP = 270 * MiB;
constexpr size_t WS_HL = 272 * MiB;
constexpr size_t WS_PB = 296 * MiB;
constexpr size_t WS_LSE = 304 * MiB;
constexpr size_t WS_ASC = 307 * MiB;
constexpr size_t WS_SLOT = 308 * MiB;
constexpr size_t SLOT_BYTES = 64 * MiB;
constexpr size_t WS_PT = WS_SLOT + 13 * SLOT_BYTES;
constexpr size_t WS_END = WS_PT + 16 * MiB;
constexpr size_t SLOT_ELEMS = (size_t)S * D;

DI float bf2f(unsigned short b) { return __uint_as_float(((unsigned)b) << 16); }
DI float bflo(unsigned w) { return __uint_as_float(w << 16); }
DI float bfhi(unsigned w) { return __uint_as_float(w & 0xffff0000u); }
typedef __bf16 bf16v2_t __attribute__((ext_vector_type(2)));
DI unsigned cvt_pk_bf16(float lo, float hi) { bf16v2_t v; v.x = (__bf16)lo; v.y = (__bf16)hi; return __builtin_bit_cast(unsigned, v); }
DI unsigned short f2bf(float f) { return (unsigned short)(cvt_pk_bf16(f, 0.f) & 0xffffu); }
template <int CTRL> DI float dpp_mov(float v) { return __int_as_float(__builtin_amdgcn_update_dpp(0, __float_as_int(v), CTRL, 0xf, 0xf, true)); }
#define DPP_XOR1 0xB1
#define DPP_XOR2 0x4E
#define DPP_HMIRROR 0x141
#define DPP_MIRROR 0x140
DI float row16_sum(float v) { v += dpp_mov<DPP_XOR1>(v); v += dpp_mov<DPP_XOR2>(v); v += dpp_mov<DPP_HMIRROR>(v); v += dpp_mov<DPP_MIRROR>(v); return v; }
DI float oct_sum(float v) { v += dpp_mov<DPP_XOR1>(v); v += dpp_mov<DPP_XOR2>(v); v += dpp_mov<DPP_HMIRROR>(v); return v; }
DI float wave_sum(float v) {
    v = row16_sum(v);
    const int iv = __float_as_int(v);
    return (__int_as_float(__builtin_amdgcn_readlane(iv, 0)) + __int_as_float(__builtin_amdgcn_readlane(iv, 16))) + (__int_as_float(__builtin_amdgcn_readlane(iv, 32)) + __int_as_float(__builtin_amdgcn_readlane(iv, 48)));
}
DI float rows_sum(float v) { auto a = __builtin_amdgcn_permlane16_swap(__float_as_uint(v), __float_as_uint(v), false, false); v = __uint_as_float(a[0]) + __uint_as_float(a[1]);
    auto b = __builtin_amdgcn_permlane32_swap(__float_as_uint(v), __float_as_uint(v), false, false); return __uint_as_float(b[0]) + __uint_as_float(b[1]); }
DI float rows_max(float v) { auto a = __builtin_amdgcn_permlane16_swap(__float_as_uint(v), __float_as_uint(v), false, false); v = fmaxf(__uint_as_float(a[0]), __uint_as_float(a[1]));
    auto b = __builtin_amdgcn_permlane32_swap(__float_as_uint(v), __float_as_uint(v), false, false); return fmaxf(__uint_as_float(b[0]), __uint_as_float(b[1])); }
#define DPP_QREV 0x1B
DI float wave_sum8(const float (&v)[8], int lane) {
    const bool b0 = lane & 1, b1 = lane & 2, b2 = lane & 4;
    float t[4], u[2];
#pragma unroll
    for (int i = 0; i < 4; ++i) { const float keep = b0 ? v[i + 4] : v[i], send = b0 ? v[i] : v[i + 4]; t[i] = keep + dpp_mov<DPP_XOR1>(send); }
#pragma unroll
    for (int i = 0; i < 2; ++i) { const float keep = b1 ? t[i + 2] : t[i], send = b1 ? t[i] : t[i + 2]; u[i] = keep + dpp_mov<DPP_XOR2>(send); }
    const float keep = b2 ? u[1] : u[0], send = b2 ? u[0] : u[1];
    float w = keep + dpp_mov<DPP_QREV>(dpp_mov<DPP_HMIRROR>(send));
    w += dpp_mov<DPP_MIRROR>(dpp_mov<DPP_HMIRROR>(w));
    return rows_sum(w);
}
constexpr int bitrev3(int e) { return ((e & 1) << 2) | (e & 2) | ((e >> 2) & 1); }
DI float wave_max(float v) {
    v = fmaxf(v, dpp_mov<DPP_XOR1>(v)); v = fmaxf(v, dpp_mov<DPP_XOR2>(v)); v = fmaxf(v, dpp_mov<DPP_HMIRROR>(v)); v = fmaxf(v, dpp_mov<DPP_MIRROR>(v));
    const int iv = __float_as_int(v);
    return fmaxf(fmaxf(__int_as_float(__builtin_amdgcn_readlane(iv, 0)), __int_as_float(__builtin_amdgcn_readlane(iv, 16))), fmaxf(__int_as_float(__builtin_amdgcn_readlane(iv, 32)), __int_as_float(__builtin_amdgcn_readlane(iv, 48))));
}
DI unsigned q8(float v) { return (unsigned)__float2int_rn(v) & 0xffu; }
DI unsigned pack4_i8(float a, float b, float c, float d) { return q8(a) | (q8(b) << 8) | (q8(c) << 16) | (q8(d) << 24); }
DI float rsqrt_fast(float x) { return __builtin_amdgcn_rsqf(x); }
DI float sigmoidf_(float x) { return 1.f / (1.f + __expf(-x)); }
#define LDS_WAIT() asm volatile("s_waitcnt lgkmcnt(0)" ::: "memory")
#define VM_WAIT() asm volatile("s_waitcnt vmcnt(0)" ::: "memory")
#ifndef MK_ONE_LAUNCH
#define MK_ONE_LAUNCH 1
#endif
namespace pg8 {
#define PG8_LAS __attribute__((address_space(3)))
typedef unsigned short bf16_t;
constexpr int BM = 256, BK = 64, HALF = 128, HTB = HALF * BK * 2  , STAGE_BYTES = 8 * HTB, NXCD = 8, WGM = 8;

__host__ __device__ __forceinline__ int lds_byte(int r, int c) { const int st = (r >> 4) * 2 + (c >> 5), rr = r & 15, cc = c & 31, ob = rr * 64 + cc * 2; return st * 1024 + (ob ^ (((ob >> 9) & 1) << 5)); }
__host__ __device__ __forceinline__ void stage_rc(int b, int& R, int& C) { const int st = b / 1024, sb = b % 1024, swz = sb ^ (((sb >> 9) & 1) << 5); R = (st >> 1) * 16 + swz / 64; C = (st & 1) * 32 + (swz % 64) / 2; }
__host__ __device__ __forceinline__ int perm32(int rho) { const int n = rho >> 4, i = rho & 15; return 8 * (i >> 2) + 4 * n + (i & 3); }

typedef int i32x4 __attribute__((ext_vector_type(4)));
template <class ACC> __device__ __forceinline__ ACC mma_sel(const bf16x8& a, const bf16x8& b, const ACC& c);
template <> __device__ __forceinline__ f32x4 mma_sel<f32x4>(const bf16x8& a, const bf16x8& b, const f32x4& c) { return __builtin_amdgcn_mfma_f32_16x16x32_bf16(a, b, c, 0, 0, 0); }
template <> __device__ __forceinline__ i32x4 mma_sel<i32x4>(const bf16x8& a, const bf16x8& b, const i32x4& c) { return __builtin_amdgcn_mfma_i32_16x16x64_i8(__builtin_bit_cast(i32x4, a), __builtin_bit_cast(i32x4, b), c, 0, 0, 0); }
struct Unit { int pm, pn, aux; };
struct Gemm { const bf16_t* A; const bf16_t* Bt; int K; };

template <class Tab> struct MultiOrder {
    int G, c;
    __device__ __forceinline__ bool next(int i, Unit& u) const {
        int L = i * G + c;
#pragma unroll
        for (int j = 0; j < Tab::NP; ++j) {
            const int nM = Tab::nM(j), nN = Tab::nN(j), nwg = nM * nN;
            if (L < nwg) {
                int wgid = L; { const int q = nwg / NXCD, r = nwg % NXCD, xcd = wgid % NXCD, off = wgid / NXCD; wgid = (xcd < r ? xcd * (q + 1) : r * (q + 1) + (xcd - r) * q) + off; }
                const int nig = WGM * nN, gid = wgid / nig, fm = gid * WGM, gsz = (nM - fm) < WGM ? (nM - fm) : WGM;
                u.pm = Tab::pm0(j) + fm + ((wgid % nig) % gsz); u.pn = Tab::pn0(j) + (wgid % nig) / gsz; u.aux = j; return true;
            }
            L -= nwg;
        }
        return false;
    }
    __device__ __forceinline__ void a_ready(const Unit&) const {}
    __device__ __forceinline__ void done(const Unit&) const {}
};
template <class Epi, class Sched, bool ALIGN_EPI = false, bool SP2 = false>
__device__ __forceinline__ void gemm_phase(PG8_LAS unsigned char* lds, const Gemm g, const Sched& S, const Epi& E, const int tid) {
    const int wid = __builtin_amdgcn_readfirstlane(tid >> 6), lane = tid & 63, wr = wid >> 2, wc = wid & 3, fr = lane & 15, fq = lane >> 4;
    const int K = g.K, nt = K / BK;
    unsigned voffA[2], voffB[2];
#pragma unroll
    for (int i = 0; i < 2; ++i) { int R, C; stage_rc(tid * 16 + i * 8192, R, C); const int Rb = Epi::PERM ? ((R & ~31) + perm32(R & 31)) : R;
        voffA[i] = (unsigned)(R * K + C) * 2u; voffB[i] = (unsigned)(Rb * K + C) * 2u; }
    const size_t kstep = (size_t)(BK * 2);
    const size_t hstep = (size_t)HALF * K * 2;
    const size_t tstep = 2 * hstep;
    const unsigned ldsw = (unsigned)wid * 1024u;
    const int aoff = lds_byte(wr * 64 + fr, fq * 8), boff = lds_byte(wc * 32 + fr, fq * 8);
#define PG8_SA(b, h) (((b) * 2 + (h)) * HTB)
#define PG8_SB(b, h) ((4 + (b) * 2 + (h)) * HTB)
#define PG8_STAGE(bufoff, gbase, voff) do { _Pragma("unroll") for (int _i = 0; _i < 2; ++_i) \
        __builtin_amdgcn_global_load_lds((const unsigned*)((const char*)(gbase) + (voff)[_i]), (PG8_LAS unsigned*)(lds + (bufoff) + ldsw + _i * 8192), 16, 0, 0); } while (0)
#define PG8_LDA(dst, b, h) do { _Pragma("unroll") for (int m = 0; m < 4; ++m) _Pragma("unroll") for (int k = 0; k < 2; ++k) dst[m][k] = *(const PG8_LAS bf16x8*)(lds + PG8_SA(b, h) + aoff + m * 2048 + k * 1024); } while (0)
#define PG8_LDB(dst, b, h) do { _Pragma("unroll") for (int n = 0; n < 2; ++n) _Pragma("unroll") for (int k = 0; k < 2; ++k) dst[n][k] = *(const PG8_LAS bf16x8*)(lds + PG8_SB(b, h) + boff + n * 2048 + k * 1024); } while (0)
#define PG8_MMA(ai, bj, At, Bt) do { __builtin_amdgcn_s_setprio(1); _Pragma("unroll") for (int m = 0; m < 4; ++m) _Pragma("unroll") for (int n = 0; n < 2; ++n) _Pragma("unroll") for (int k = 0; k < 2; ++k) \
        acc[ai][bj][m][n] = mma_sel<acc_t>(Bt[n][k], At[m][k], acc[ai][bj][m][n]); __builtin_amdgcn_s_setprio(0); } while (0)
#define PG8_WAIT_V(n) asm volatile("s_waitcnt vmcnt(" #n ")" ::: "memory")
#define PG8_WAIT_L(n) asm volatile("s_waitcnt lgkmcnt(" #n ")" ::: "memory")
#define PG8_BAR __builtin_amdgcn_s_barrier()
#define PG8_SCHED __builtin_amdgcn_sched_barrier(0)
    Unit cur, nxt; int ui = 0;
    if (!S.next(0, cur)) return;
    typedef typename Epi::acc_t acc_t; acc_t acc[2][2][4][2];
#pragma unroll
    for (int a = 0; a < 2; ++a)
#pragma unroll
        for (int b = 0; b < 2; ++b)
#pragma unroll
            for (int m = 0; m < 4; ++m)
#pragma unroll
                for (int n = 0; n < 2; ++n) acc[a][b][m][n] = acc_t{};
    bf16x8 At[4][2], B0[2][2], B1[2][2];
    const char* cA = (const char*)g.A + (size_t)cur.pm * tstep; const char* cB = (const char*)g.Bt + (size_t)cur.pn * tstep;
    S.a_ready(cur);
    if constexpr (SP2) {
        PG8_STAGE(PG8_SB(0, 0), cB, voffB); PG8_STAGE(PG8_SB(0, 1), cB + hstep, voffB); PG8_STAGE(PG8_SA(0, 0), cA, voffA); PG8_STAGE(PG8_SA(0, 1), cA + hstep, voffA);
        if (wr == 1) PG8_BAR;
        PG8_WAIT_V(2); PG8_BAR;
        PG8_STAGE(PG8_SB(1, 0), cB + kstep, voffB); PG8_STAGE(PG8_SA(1, 0), cA + kstep, voffA); PG8_STAGE(PG8_SB(1, 1), cB + hstep + kstep, voffB);
        PG8_WAIT_V(6); PG8_BAR;
    } else {
        PG8_STAGE(PG8_SB(0, 0), cB, voffB); PG8_STAGE(PG8_SA(0, 0), cA, voffA); PG8_STAGE(PG8_SB(0, 1), cB + hstep, voffB); PG8_STAGE(PG8_SA(0, 1), cA + hstep, voffA);
        if (wr == 1) PG8_BAR;
        PG8_WAIT_V(4); PG8_BAR;
        PG8_STAGE(PG8_SB(1, 0), cB + kstep, voffB); PG8_STAGE(PG8_SA(1, 0), cA + kstep, voffA); PG8_STAGE(PG8_SB(1, 1), cB + hstep + kstep, voffB);
        PG8_WAIT_V(6); PG8_BAR;
    }
    for (;;) {
        const bool has_next = S.next(ui + 1, nxt);
        const char* nA = has_next ? (const char*)g.A + (size_t)nxt.pm * tstep : cA; const char* nB = has_next ? (const char*)g.Bt + (size_t)nxt.pn * tstep : cB;
        for (int t = 0; t < nt; t += 2) {
            const bool last = (t == nt - 2);
            const char* a1 = cA + (size_t)(t + 1) * kstep;
            const char* a2 = last ? nA : cA + (size_t)(t + 2) * kstep; const char* b2 = last ? nB : cB + (size_t)(t + 2) * kstep;
            const char* a3 = a2 + kstep; const char* b3 = b2 + kstep;
            if (last && has_next) S.a_ready(nxt);
            if constexpr (SP2) {
            PG8_LDB(B0, 0, 0); PG8_LDB(B1, 0, 1); PG8_SCHED; PG8_LDA(At, 0, 0); PG8_STAGE(PG8_SA(1, 1), a1 + hstep, voffA);
            PG8_WAIT_V(8); PG8_WAIT_L(0); PG8_BAR; PG8_MMA(0, 0, At, B0); PG8_MMA(0, 1, At, B1); PG8_BAR; PG8_SCHED;
            PG8_LDA(At, 0, 1); PG8_STAGE(PG8_SB(0, 0), b2, voffB); PG8_STAGE(PG8_SB(0, 1), b2 + hstep, voffB); PG8_STAGE(PG8_SA(0, 0), a2, voffA);
            PG8_WAIT_V(8); PG8_WAIT_L(0); PG8_BAR; PG8_MMA(1, 0, At, B0); PG8_MMA(1, 1, At, B1); PG8_BAR; PG8_SCHED;
            PG8_LDB(B0, 1, 0); PG8_LDB(B1, 1, 1); PG8_SCHED; PG8_LDA(At, 1, 0); PG8_STAGE(PG8_SA(0, 1), a2 + hstep, voffA);
            PG8_WAIT_V(8); PG8_WAIT_L(0); PG8_BAR; PG8_MMA(0, 0, At, B0); PG8_MMA(0, 1, At, B1); PG8_BAR; PG8_SCHED;
            PG8_LDA(At, 1, 1); PG8_STAGE(PG8_SB(1, 0), b3, voffB); PG8_STAGE(PG8_SB(1, 1), b3 + hstep, voffB); PG8_STAGE(PG8_SA(1, 0), a3, voffA);
            PG8_WAIT_V(8); PG8_WAIT_L(0); PG8_BAR; PG8_MMA(1, 0, At, B0); PG8_MMA(1, 1, At, B1); PG8_BAR; PG8_SCHED;
            } else {
            PG8_LDB(B0, 0, 0); PG8_SCHED; PG8_LDA(At, 0, 0); PG8_STAGE(PG8_SA(1, 1), a1 + hstep, voffA);
            PG8_WAIT_L(8); PG8_BAR; PG8_WAIT_L(0); PG8_MMA(0, 0, At, B0); PG8_BAR; PG8_SCHED;
            PG8_LDB(B1, 0, 1); PG8_STAGE(PG8_SB(0, 0), b2, voffB);
            PG8_BAR; PG8_WAIT_L(0); PG8_MMA(0, 1, At, B1); PG8_BAR;
            PG8_LDA(At, 0, 1); PG8_STAGE(PG8_SA(0, 0), a2, voffA);
            PG8_BAR; PG8_WAIT_L(0); PG8_MMA(1, 0, At, B0); PG8_BAR; PG8_SCHED;
            PG8_STAGE(PG8_SB(0, 1), b2 + hstep, voffB);
            PG8_WAIT_V(6); PG8_BAR; PG8_MMA(1, 1, At, B1); PG8_BAR;
            PG8_LDB(B0, 1, 0); PG8_SCHED; PG8_LDA(At, 1, 0); PG8_STAGE(PG8_SA(0, 1), a2 + hstep, voffA);
            PG8_WAIT_L(8); PG8_BAR; PG8_WAIT_L(0); PG8_MMA(0, 0, At, B0); PG8_BAR; PG8_SCHED;
            PG8_LDB(B1, 1, 1); PG8_STAGE(PG8_SB(1, 0), b3, voffB);
            PG8_BAR; PG8_WAIT_L(0); PG8_MMA(0, 1, At, B1); PG8_BAR;
            PG8_LDA(At, 1, 1); PG8_STAGE(PG8_SA(1, 0), a3, voffA);
            PG8_BAR; PG8_WAIT_L(0); PG8_MMA(1, 0, At, B0); PG8_BAR; PG8_SCHED;
            PG8_STAGE(PG8_SB(1, 1), b3 + hstep, voffB);
            PG8_WAIT_V(6); PG8_BAR; PG8_MMA(1, 1, At, B1); PG8_BAR;
            }
        }
        if constexpr (ALIGN_EPI) { if (wr == 0) PG8_BAR; }
        if constexpr (!Epi::AFTER_DRAIN) { E(acc, cur, wr, wc, fr, fq); S.done(cur); }
        if (!has_next) break;
#pragma unroll
        for (int a = 0; a < 2; ++a)
#pragma unroll
            for (int b = 0; b < 2; ++b)
#pragma unroll
                for (int m = 0; m < 4; ++m)
#pragma unroll
                    for (int n = 0; n < 2; ++n) acc[a][b][m][n] = acc_t{};
        cur = nxt; cA = nA; cB = nB; ++ui;
        if constexpr (ALIGN_EPI) { if (wr == 1) PG8_BAR; }
    }
    PG8_WAIT_V(0);
    if constexpr (!ALIGN_EPI) { if (wr == 0) PG8_BAR; }
    PG8_BAR;
    if constexpr (Epi::AFTER_DRAIN) { E.fused(acc, cur, wr, wc, fr, fq, lds, wid, lane); S.done(cur); }
#undef PG8_SA
#undef PG8_SB
#undef PG8_STAGE
#undef PG8_LDA
#undef PG8_LDB
#undef PG8_MMA
#undef PG8_WAIT_V
#undef PG8_WAIT_L
#undef PG8_BAR
#undef PG8_SCHED
}
template <int ACT> __device__ __forceinline__ float act_f(float x) {
    if (ACT == 1) return 2.f * __builtin_amdgcn_rcpf(1.f + __expf(-2.f * x)) - 1.f;
    if (ACT == 2) return 1.f * __builtin_amdgcn_rcpf(1.f + __expf(-x));
    if (ACT == 3) return -0.6065306597f * __builtin_amdgcn_rcpf(1.f + __expf(-x));
    return x;
}
template <int ACT> __device__ __forceinline__ void store_tile_bf16(const f32x4 (&acc)[2][2][4][2], bf16_t* base, int ldc, int row0, int col0, const float* bias, int bcol0) {
    f32x4 bv[2][2];
#pragma unroll
    for (int bj = 0; bj < 2; ++bj)
#pragma unroll
        for (int n = 0; n < 2; ++n) bv[bj][n] = bias ? *(const f32x4*)(bias + bcol0 + bj * HALF + 4 * n) : (f32x4){0.f, 0.f, 0.f, 0.f};
#pragma unroll
    for (int ai = 0; ai < 2; ++ai)
#pragma unroll
        for (int m = 0; m < 4; ++m) { bf16_t* rowp = base + (size_t)(row0 + ai * HALF + m * 16) * ldc + col0;
#pragma unroll
            for (int bj = 0; bj < 2; ++bj) { f32x4 v0 = acc[ai][bj][m][0] + bv[bj][0], v1 = acc[ai][bj][m][1] + bv[bj][1];
#pragma unroll
                for (int e = 0; e < 4; ++e) { v0[e] = act_f<ACT>(v0[e]); v1[e] = act_f<ACT>(v1[e]); }
                u32x4 w; w.x = cvt_pk_bf16(v0[0], v0[1]); w.y = cvt_pk_bf16(v0[2], v0[3]); w.z = cvt_pk_bf16(v1[0], v1[1]); w.w = cvt_pk_bf16(v1[2], v1[3]);
                *(u32x4*)(rowp + bj * HALF) = w; } }
}
struct EpiPlain {
    typedef f32x4 acc_t; static constexpr bool PERM = true, AFTER_DRAIN = false;
    bf16_t* O; int ldc;
    __device__ __forceinline__ void operator()(const f32x4 (&acc)[2][2][4][2], const Unit& u, int wr, int wc, int fr, int fq) const {
        store_tile_bf16<0>(acc, O, ldc, u.pm * BM + wr * 64 + fr, u.pn * BM + wc * 32 + 8 * fq, nullptr, 0);
    }
};
struct EpiL0B {
    typedef f32x4 acc_t; static constexpr bool PERM = true, AFTER_DRAIN = false;
    bf16_t* rkv; bf16_t* hl;
    __device__ __forceinline__ void operator()(const f32x4 (&acc)[2][2][4][2], const Unit& u, int wr, int wc, int fr, int fq) const {
        const int j = u.aux, pmL = u.pm - NPANEL * j;
        if (j < 3) { store_tile_bf16<0>(acc, rkv + (size_t)j * SLOT_ELEMS, D, pmL * BM + wr * 64 + fr, (u.pn - 8 * j) * BM + wc * 32 + 8 * fq, nullptr, 0); return; }
        bf16_t* base = hl + (size_t)(j - 3) * S * 256; const int row0 = pmL * BM + wr * 64 + fr, col0 = wc * 32 + 8 * fq;
        if (j == 3) store_tile_bf16<1>(acc, base, 256, row0, col0, nullptr, 0);
        else if (j == 4) store_tile_bf16<0>(acc, base, 256, row0, col0, nullptr, 0);
        else store_tile_bf16<2>(acc, base, 256, row0, col0, nullptr, 0);
    }
};
struct EpiL0C {
    typedef f32x4 acc_t; static constexpr bool PERM = true, AFTER_DRAIN = false;
    bf16_t* out; const float* w0; const float* a0;
    __device__ __forceinline__ void operator()(const f32x4 (&acc)[2][2][4][2], const Unit& u, int wr, int wc, int fr, int fq) const {
        const int p = u.aux, src = p >> 1, pmL = u.pm - NPANEL * src, pnL = u.pn - 8 * p;
        bf16_t* base = out + (size_t)p * SLOT_ELEMS; const int row0 = pmL * BM + wr * 64 + fr, col0 = pnL * BM + wc * 32 + 8 * fq;
        if (p < 2) store_tile_bf16<3>(acc, base, D, row0, col0, w0 + p * D, col0);
        else if (p < 4) store_tile_bf16<2>(acc, base, D, row0, col0, a0 + (p - 2) * D, col0);
        else store_tile_bf16<0>(acc, base, D, row0, col0, nullptr, 0);
    }
};
struct EpiSwiGLU {
    typedef f32x4 acc_t; static constexpr bool PERM = true, AFTER_DRAIN = false;
    bf16_t* O;
    __device__ __forceinline__ void operator()(const f32x4 (&acc)[2][2][4][2], const Unit& u, int wr, int wc, int fr, int fq) const {
        const int row0 = u.pm * BM + wr * 64 + fr, col0 = u.pn * HALF + wc * 32 + 8 * fq;
#pragma unroll
        for (int ai = 0; ai < 2; ++ai)
#pragma unroll
            for (int m = 0; m < 4; ++m) { bf16_t* rowp = O + (size_t)(row0 + ai * HALF + m * 16) * FF + col0;
                float h[8];
#pragma unroll
                for (int n = 0; n < 2; ++n)
#pragma unroll
                    for (int e = 0; e < 4; ++e) { const float g = acc[ai][0][m][n][e], up = acc[ai][1][m][n][e]; h[4 * n + e] = g * up * __builtin_amdgcn_rcpf(1.f + __expf(-g)); }
                u32x4 w; w.x = cvt_pk_bf16(h[0], h[1]); w.y = cvt_pk_bf16(h[2], h[3]); w.z = cvt_pk_bf16(h[4], h[5]); w.w = cvt_pk_bf16(h[6], h[7]);
                *(u32x4*)rowp = w; }
    }
};
struct EpiPleGate {
    typedef f32x4 acc_t; static constexpr bool PERM = false, AFTER_DRAIN = false;
    float* X; const bf16_t* PP;
    __device__ __forceinline__ void operator()(const f32x4 (&acc)[2][2][4][2], const Unit& u, int wr, int wc, int fr, int fq) const {
        const int row0 = u.pm * BM + wr * 64 + fr, col0 = u.pn * BM + wc * 32 + 4 * fq;
#pragma unroll
        for (int ai = 0; ai < 2; ++ai)
#pragma unroll
            for (int m = 0; m < 4; ++m) { const size_t off = (size_t)(row0 + ai * HALF + m * 16) * D + col0;
#pragma unroll
                for (int bj = 0; bj < 2; ++bj)
#pragma unroll
                    for (int n = 0; n < 2; ++n) { const size_t o2 = off + bj * HALF + n * 16; const u32x2 pw = *(const u32x2*)(PP + o2); f32x4 xv = *(const f32x4*)(X + o2); const f32x4 a = acc[ai][bj][m][n];
                        xv[0] += bflo(pw.x) * __builtin_amdgcn_rcpf(1.f + __expf(-a[0])); xv[1] += bfhi(pw.x) * __builtin_amdgcn_rcpf(1.f + __expf(-a[1])); xv[2] += bflo(pw.y) * __builtin_amdgcn_rcpf(1.f + __expf(-a[2])); xv[3] += bfhi(pw.y) * __builtin_amdgcn_rcpf(1.f + __expf(-a[3]));
                        *(f32x4*)(X + o2) = xv; } }
    }
};
struct EpiPlainI8 {
    typedef i32x4 acc_t; static constexpr bool PERM = true, AFTER_DRAIN = false;
    bf16_t* O; int ldc; const float* asc; const float* wsc;
    __device__ __forceinline__ void operator()(const i32x4 (&acc)[2][2][4][2], const Unit& u, int wr, int wc, int fr, int fq) const {
        const int row0 = u.pm * BM + wr * 64 + fr, col0 = u.pn * BM + wc * 32 + 8 * fq;
        f32x4 ws[2][2];
#pragma unroll
        for (int bj = 0; bj < 2; ++bj)
#pragma unroll
            for (int n = 0; n < 2; ++n) ws[bj][n] = *(const f32x4*)(wsc + col0 + bj * HALF + 4 * n);
        float sav[2][4];
#pragma unroll
        for (int ai = 0; ai < 2; ++ai)
#pragma unroll
            for (int m = 0; m < 4; ++m) sav[ai][m] = asc[row0 + ai * HALF + m * 16];
#pragma unroll
        for (int ai = 0; ai < 2; ++ai)
#pragma unroll
            for (int m = 0; m < 4; ++m) { const int row = row0 + ai * HALF + m * 16; const float sa = sav[ai][m]; bf16_t* rowp = O + (size_t)row * ldc + col0;
#pragma unroll
                for (int bj = 0; bj < 2; ++bj) { float v[8];
#pragma unroll
                    for (int n = 0; n < 2; ++n) { const f32x4 sw = ws[bj][n] * sa;
#pragma unroll
                        for (int e = 0; e < 4; ++e) v[4 * n + e] = (float)acc[ai][bj][m][n][e] * sw[e]; }
                    u32x4 w; w.x = cvt_pk_bf16(v[0], v[1]); w.y = cvt_pk_bf16(v[2], v[3]); w.z = cvt_pk_bf16(v[4], v[5]); w.w = cvt_pk_bf16(v[6], v[7]);
                    *(u32x4*)(rowp + bj * HALF) = w; } }
    }
};
struct EpiSwiGLUI8 {
    typedef i32x4 acc_t; static constexpr bool PERM = true, AFTER_DRAIN = false;
    bf16_t* O; const float* asc; const float* wsc;
    __device__ __forceinline__ void operator()(const i32x4 (&acc)[2][2][4][2], const Unit& u, int wr, int wc, int fr, int fq) const {
        const int row0 = u.pm * BM + wr * 64 + fr, col0 = u.pn * HALF + wc * 32 + 8 * fq, bcol0 = u.pn * BM + wc * 32 + 8 * fq;
        f32x4 ws[2][2];
#pragma unroll
        for (int bj = 0; bj < 2; ++bj)
#pragma unroll
            for (int n = 0; n < 2; ++n) ws[bj][n] = *(const f32x4*)(wsc + bcol0 + bj * HALF + 4 * n);
        float sav[2][4];
#pragma unroll
        for (int ai = 0; ai < 2; ++ai)
#pragma unroll
            for (int m = 0; m < 4; ++m) sav[ai][m] = asc[row0 + ai * HALF + m * 16];
#pragma unroll
        for (int ai = 0; ai < 2; ++ai)
#pragma unroll
            for (int m = 0; m < 4; ++m) { const int row = row0 + ai * HALF + m * 16; const float sa = sav[ai][m]; bf16_t* rowp = O + (size_t)row * FF + col0;
                float h[8];
#pragma unroll
                for (int n = 0; n < 2; ++n)
#pragma unroll
                    for (int e = 0; e < 4; ++e) { const float g = (float)acc[ai][0][m][n][e] * (sa * ws[0][n][e]), up = (float)acc[ai][1][m][n][e] * (sa * ws[1][n][e]); h[4 * n + e] = g * up * __builtin_amdgcn_rcpf(1.f + __expf(-g)); }
                u32x4 w; w.x = cvt_pk_bf16(h[0], h[1]); w.y = cvt_pk_bf16(h[2], h[3]); w.z = cvt_pk_bf16(h[4], h[5]); w.w = cvt_pk_bf16(h[6], h[7]);
                *(u32x4*)rowp = w; }
    }
};
struct EpiPleGateI8 {
    typedef i32x4 acc_t; static constexpr bool PERM = false, AFTER_DRAIN = false;
    const bf16_t* XI; bf16_t* XB; float* XF; const bf16_t* PP; const float* asc; const float* wsc;
    __device__ __forceinline__ void operator()(const i32x4 (&acc)[2][2][4][2], const Unit& u, int wr, int wc, int fr, int fq) const {
        const int row0 = u.pm * BM + wr * 64 + fr, col0 = u.pn * BM + wc * 32 + 4 * fq;
        f32x4 ws[2][2];
#pragma unroll
        for (int bj = 0; bj < 2; ++bj)
#pragma unroll
            for (int n = 0; n < 2; ++n) ws[bj][n] = *(const f32x4*)(wsc + col0 + bj * HALF + n * 16);
        float sav[2][4];
#pragma unroll
        for (int ai = 0; ai < 2; ++ai)
#pragma unroll
            for (int m = 0; m < 4; ++m) sav[ai][m] = asc[row0 + ai * HALF + m * 16];
        u32x2 pw[2][4], xw[2][4];
#define GATE_LD(buf, i) do { const size_t off_ = (size_t)(row0 + ((i) >> 2) * HALF + ((i) & 3) * 16) * D + col0; _Pragma("unroll") for (int q_ = 0; q_ < 4; ++q_) { const size_t o2_ = off_ + (q_ >> 1) * HALF + (q_ & 1) * 16; \
            pw[buf][q_] = *(const u32x2*)(PP + o2_); xw[buf][q_] = *(const u32x2*)(XI + o2_); } } while (0)
        GATE_LD(0, 0);
#pragma unroll
        for (int i = 0; i < 8; ++i) { const int ai = i >> 2, m = i & 3; const float sa = sav[ai][m]; const size_t off = (size_t)(row0 + ai * HALF + m * 16) * D + col0;
            if (i + 1 < 8) GATE_LD((i + 1) & 1, i + 1);
#pragma unroll
            for (int q = 0; q < 4; ++q) { const int bj = q >> 1, n = q & 1; const size_t o2 = off + bj * HALF + n * 16; const u32x2 pv = pw[i & 1][q], xq = xw[i & 1][q]; const i32x4 ia = acc[ai][bj][m][n]; const f32x4 wv = ws[bj][n];
                f32x4 xv = (f32x4){bflo(xq.x), bfhi(xq.x), bflo(xq.y), bfhi(xq.y)};
                xv[0] += bflo(pv.x) * __builtin_amdgcn_rcpf(1.f + __expf(-(float)ia[0] * sa * wv[0])); xv[1] += bfhi(pv.x) * __builtin_amdgcn_rcpf(1.f + __expf(-(float)ia[1] * sa * wv[1]));
                xv[2] += bflo(pv.y) * __builtin_amdgcn_rcpf(1.f + __expf(-(float)ia[2] * sa * wv[2])); xv[3] += bfhi(pv.y) * __builtin_amdgcn_rcpf(1.f + __expf(-(float)ia[3] * sa * wv[3]));
                if (XF) *(f32x4*)(XF + o2) = xv; else { u32x2 w; w.x = cvt_pk_bf16(xv[0], xv[1]); w.y = cvt_pk_bf16(xv[2], xv[3]); *(u32x2*)(XB + o2) = w; } } }
#undef GATE_LD
    }
};
struct TabL0B { static constexpr int NP = 6; static __device__ constexpr int nM(int) { return NPANEL; } static __device__ constexpr int nN(int j) { return j < 3 ? 8 : 1; }
    static __device__ constexpr int pm0(int j) { return NPANEL * j; } static __device__ constexpr int pn0(int j) { return j < 3 ? 8 * j : 24 + (j - 3); } };
struct TabL0C { static constexpr int NP = 5; static __device__ constexpr int nM(int) { return NPANEL; } static __device__ constexpr int nN(int) { return 8; }
    static __device__ constexpr int pm0(int p) { return NPANEL * (p >> 1); } static __device__ constexpr int pn0(int p) { return 8 * p; } };
template <int NN> struct TabOne { static constexpr int NP = 1; static __device__ constexpr int nM(int) { return NPANEL; } static __device__ constexpr int nN(int) { return NN; }
    static __device__ constexpr int pm0(int) { return 0; } static __device__ constexpr int pn0(int) { return 0; } };
}
typedef pg8::Unit Unit;
#define XB_TMO      128
#define XB_XCNT(j)  (256  + 64 * (j))
#define XB_XSUB(j)  (1280 + 64 * (j))
#define XB_XGEN(j)  (2304 + 64 * (j))
#define XB_TOP      3328
#define XB_TOPGEN   3392
#define XCD_BAR_WORDS 3456
#define XB_SPIN_CAP (1u << 21)

__device__ __forceinline__ unsigned xb_ld(unsigned* p)              { return __hip_atomic_load(p, __ATOMIC_RELAXED, __HIP_MEMORY_SCOPE_AGENT); }
__device__ __forceinline__ unsigned xb_add(unsigned* p, unsigned v) { return __hip_atomic_fetch_add(p, v, __ATOMIC_RELAXED, __HIP_MEMORY_SCOPE_AGENT); }
__device__ __forceinline__ unsigned xb_xcc_id() { return (unsigned)__builtin_amdgcn_s_getreg((3 << 11) | 20) & 0xFu; }
#define XB_SPIN(cond, bar) do { unsigned _sp = 0; while (cond) { __builtin_amdgcn_s_sleep(1); \
    if ((++_sp & 255u) == 0u) { if (xb_ld(&(bar)[XB_TMO])) break; if (_sp > XB_SPIN_CAP) { atomicAdd(&(bar)[XB_TMO], 1u); break; } } } } while (0)

struct XcdBarrier {
    unsigned* bar; unsigned x;
    volatile LAS unsigned* st;
    int w;
};

__device__ __forceinline__ XcdBarrier xcd_barrier_post(unsigned* bar, volatile LAS unsigned* st) {
    XcdBarrier b; b.bar = bar; b.x = xb_xcc_id(); b.st = st; b.w = 0;
    if (threadIdx.x == 0) (void)xb_add(&bar[XB_XCNT(b.x)], 1u);
    return b;
}
__device__ __forceinline__ void xcd_barrier_complete(unsigned* bar, unsigned x, unsigned& nloc, unsigned& nx) {
    const unsigned G = gridDim.x * gridDim.y * gridDim.z;
    unsigned sum, cnt, mine, sp = 0u;
    for (;;) {
        sum = 0u; cnt = 0u; mine = 0u;
#pragma unroll
        for (unsigned j = 0; j < 16; ++j) { const unsigned c = xb_ld(&bar[XB_XCNT(j)]); sum += c; cnt += (c > 0u) ? 1u : 0u; mine = (j == x) ? c : mine; }
        if (sum == G) break;
        __builtin_amdgcn_s_sleep(1);
        if ((++sp & 255u) == 0u) { if (xb_ld(&bar[XB_TMO])) break; if (sp > XB_SPIN_CAP) { atomicAdd(&bar[XB_TMO], 1u); break; } }
    }
    nloc = mine > 0u ? mine : 1u; nx = cnt > 0u ? cnt : 1u;
}

__device__ __forceinline__ void xcd_barrier(const XcdBarrier& b) {
    asm volatile("s_waitcnt vmcnt(0)" ::: "memory");
    __syncthreads();
    int ln_; asm volatile("v_mbcnt_lo_u32_b32 %0, -1, 0\n\tv_mbcnt_hi_u32_b32 %0, -1, %0" : "=v"(ln_));
    if (b.w == 0 && ln_ == 0) {
        unsigned* bar = b.bar;
        __builtin_amdgcn_s_waitcnt(0);
        unsigned nloc = b.st[0], nx = b.st[1];
        if (nloc == 0u) { xcd_barrier_complete(bar, b.x, nloc, nx); b.st[0] = nloc; b.st[1] = nx; }
        const unsigned old = xb_add(&bar[XB_XSUB(b.x)], 1u);
        const unsigned gen = old / nloc;
        if (old + 1u == (gen + 1u) * nloc) {
            __builtin_amdgcn_fence(__ATOMIC_RELEASE, "agent");
            asm volatile("s_waitcnt vmcnt(0)" ::: "memory");
            const unsigned og = xb_add(&bar[XB_TOP], 1u);
            const unsigned tg = og / nx;
            if (og + 1u == (tg + 1u) * nx) xb_add(&bar[XB_TOPGEN], 1u);
            else XB_SPIN(xb_ld(&bar[XB_TOPGEN]) == tg, bar);
            __builtin_amdgcn_fence(__ATOMIC_ACQUIRE, "agent");
            xb_add(&bar[XB_XGEN(b.x)], 1u);
            asm volatile("s_waitcnt vmcnt(0)" ::: "memory");
        } else {
            XB_SPIN(xb_ld(&bar[XB_XGEN(b.x)]) == gen, bar);
            __builtin_amdgcn_fence(__ATOMIC_ACQUIRE, "agent");
            asm volatile("s_waitcnt vmcnt(0)" ::: "memory");
        }
    }
    __syncthreads();
}
constexpr int NWAVES = 8;
constexpr int RING_BYTES = 131072, LDSCTL_OFF = RING_BYTES, MISC_OFF = LDSCTL_OFF + 320, LDS_BYTES = 147456;
constexpr int CW_BAR = 4096;

struct Args { const float* in[29]; float* out; unsigned char* ws; int slab_lo, slab_hi, ph_lo, ph_hi, use_bar, do_pro; };
typedef const __attribute__((address_space(4))) Args* ArgsP;
DI ArgsP args_ptr() { ArgsP p = (ArgsP)__builtin_amdgcn_kernarg_segment_ptr(); asm volatile("" : "+s"(p)); return p; }

struct Frame {
    LAS unsigned char* lds; unsigned char* ldsg;
    int tid, lane, wave, vcu, G, gw, NGW;
};

DI void wht8(float (&f)[8]) {
#pragma unroll
    for (int st = 4; st >= 1; st >>= 1)
#pragma unroll
        for (int i = 0; i < 8; ++i) if (!(i & st)) { const float a = f[i], b = f[i + st]; f[i] = a + b; f[i + st] = a - b; }
}
DI int w_row(int nn, int rowoff, int mode) { return mode == 1 ? (nn < FF ? 256 * (nn >> 7) + (nn & 127) : 256 * ((nn - FF) >> 7) + 128 + ((nn - FF) & 127)) : rowoff + nn; }
template <bool RANGE, bool I8> DI void tr_job(const float* src, const int K, const int N, const int klo, const int khi, void* dst, const int pitch, const int rowoff, const int mode, const float* wsc,
                                              LAS float* scr, const int gw, const int NGW, const int lane, const int rot = 0, const float* part = nullptr, float* wsc_out = nullptr) {
    const int nblk = N >> 5, nitems = (K >> 6) * nblk, r8 = lane >> 3, c4 = lane & 7, hf = lane >> 5, n = lane & 31;
    f32x4 v[8]; float scn = 0.f;
#define TR_LOAD(it_) do { const int kb_ = (it_) / nblk, nb_ = (it_) - kb_ * nblk; const float* sp_ = src + nb_ * 32 + 4 * c4; \
        _Pragma("unroll") for (int i = 0; i < 8; ++i) { const int kv = kb_ * 64 + 8 * i + r8; \
            if (RANGE) { const bool ok = kv >= klo && kv < khi; const f32x4 t_ = *(const f32x4*)(sp_ + (size_t)(ok ? kv - klo : 0) * N); v[i] = ok ? t_ : (f32x4){0.f, 0.f, 0.f, 0.f}; } \
            else v[i] = *(const f32x4*)(sp_ + (size_t)kv * N); } \
        if (I8) { const int rw_ = w_row(nb_ * 32 + n, rowoff, mode); scn = rot ? fmaxf(fmaxf(part[rw_], part[2048 + rw_]), fmaxf(part[4096 + rw_], part[6144 + rw_])) : wsc[rw_]; } } while (0)
    int it = gw; if (it < nitems) TR_LOAD(it);
    for (; it < nitems; it += NGW) {
#pragma unroll
        for (int i = 0; i < 8; ++i) *(LAS f32x4*)(scr + (8 * i + r8) * 36 + 4 * c4) = v[i];
        const float sc = scn; const int kb = it / nblk, nb = it - kb * nblk;
        if (it + NGW < nitems) TR_LOAD(it + NGW);
        LDS_WAIT(); asm volatile("" ::: "memory");
        const int row = w_row(nb * 32 + n, rowoff, mode);
        if (I8 && rot && kb == 0 && hf == 0) wsc_out[row] = sc;
        const LAS float* sp = scr + (32 * hf) * 36 + n;
        float f[32];
#pragma unroll
        for (int j = 0; j < 32; ++j) f[j] = sp[j * 36];
        if (I8 && rot) {
#pragma unroll
            for (int q = 0; q < 4; ++q) { float t[8];
#pragma unroll
                for (int e = 0; e < 8; ++e) t[e] = f[8 * q + e];
                wht8(t);
#pragma unroll
                for (int e = 0; e < 8; ++e) f[8 * q + e] = t[e]; }
#pragma unroll
            for (int q = 0; q < 2; ++q)
#pragma unroll
                for (int e = 0; e < 8; ++e) { const float a = f[16 * q + e], b = f[16 * q + 8 + e]; f[16 * q + e] = a + b; f[16 * q + 8 + e] = a - b; }
#pragma unroll
            for (int j = 0; j < 16; ++j) { const float a = f[j], b = f[j + 16]; f[j] = (a + b) * 0.03125f; f[j + 16] = (a - b) * 0.03125f; } }
        if (I8) { const float inv = sc > 0.f ? 1.f / sc : 0.f; u32x4 o[2];
#pragma unroll
            for (int q = 0; q < 2; ++q) { o[q].x = pack4_i8(f[16 * q] * inv, f[16 * q + 1] * inv, f[16 * q + 2] * inv, f[16 * q + 3] * inv); o[q].y = pack4_i8(f[16 * q + 4] * inv, f[16 * q + 5] * inv, f[16 * q + 6] * inv, f[16 * q + 7] * inv);
                o[q].z = pack4_i8(f[16 * q + 8] * inv, f[16 * q + 9] * inv, f[16 * q + 10] * inv, f[16 * q + 11] * inv); o[q].w = pack4_i8(f[16 * q + 12] * inv, f[16 * q + 13] * inv, f[16 * q + 14] * inv, f[16 * q + 15] * inv); }
            unsigned char* d = (unsigned char*)dst + (size_t)row * pitch + kb * 64 + 32 * hf; *(u32x4*)d = o[0]; *(u32x4*)(d + 16) = o[1]; }
        else { bf16* d = (bf16*)dst + (size_t)row * pitch + kb * 64 + 32 * hf;
#pragma unroll
            for (int q = 0; q < 4; ++q) { u32x4 o; o.x = cvt_pk_bf16(f[8 * q], f[8 * q + 1]); o.y = cvt_pk_bf16(f[8 * q + 2], f[8 * q + 3]); o.z = cvt_pk_bf16(f[8 * q + 4], f[8 * q + 5]); o.w = cvt_pk_bf16(f[8 * q + 6], f[8 * q + 7]); *(u32x4*)(d + 8 * q) = o; } }
        LDS_WAIT(); asm volatile("" ::: "memory");
    }
#undef TR_LOAD
}
DI void col_absmax_strip(const float* src, int K, int N, int rowoff, int mode, float* wsc, int strip, int lane) {
    const int n0 = strip * 32, r8 = lane >> 3, c4 = lane & 7; const float* sp = src + n0 + 4 * c4;
    f32x4 m = (f32x4){0.f, 0.f, 0.f, 0.f};
    f32x4 cur[8];
#pragma unroll
    for (int i = 0; i < 8; ++i) cur[i] = *(const f32x4*)(sp + (size_t)(r8 + 8 * i) * N);
    for (int k = r8; k < K; k += 64) { f32x4 nxt[8]; const bool more = k + 64 < K;
        if (more) {
#pragma unroll
            for (int i = 0; i < 8; ++i) nxt[i] = *(const f32x4*)(sp + (size_t)(k + 64 + 8 * i) * N); }
#pragma unroll
        for (int i = 0; i < 8; ++i)
#pragma unroll
            for (int e = 0; e < 4; ++e) m[e] = fmaxf(m[e], fabsf(cur[i][e]));
        if (more) {
#pragma unroll
            for (int i = 0; i < 8; ++i) cur[i] = nxt[i]; } }
#pragma unroll
    for (int e = 0; e < 4; ++e) { float x = m[e]; x = fmaxf(x, dpp_mov<DPP_MIRROR>(dpp_mov<DPP_HMIRROR>(x))); m[e] = rows_max(x); }
    if (lane < 8) {
#pragma unroll
        for (int e = 0; e < 4; ++e) wsc[w_row(n0 + 4 * lane + e, rowoff, mode)] = m[e] * (1.f / 127.f); }
}
DI void col_absmax_strip_rot(const float* src_, int K, int N, int rowoff, int mode, float* wsc, int strip, int lane, int kbeg) {
    const float* src = src_ + (size_t)kbeg * N;
    const int n0 = strip * 32, r8 = lane >> 3, c4 = lane & 7; const float* sp = src + n0 + 4 * c4 + (size_t)(8 * r8) * N;
    f32x4 m = (f32x4){0.f, 0.f, 0.f, 0.f}; const float sg2 = (r8 & 1) ? -1.f : 1.f, sg4 = (r8 & 2) ? -1.f : 1.f;
    f32x4 cur[8];
#pragma unroll
    for (int i = 0; i < 8; ++i) cur[i] = *(const f32x4*)(sp + (size_t)i * N);
    for (int k = 0; k < K; k += 64) { f32x4 nxt[8]; const bool more = k + 64 < K;
        if (more) {
#pragma unroll
            for (int i = 0; i < 8; ++i) nxt[i] = *(const f32x4*)(sp + (size_t)(k + 64 + i) * N); }
#pragma unroll
        for (int e = 0; e < 4; ++e) { float t[8];
#pragma unroll
            for (int i = 0; i < 8; ++i) t[i] = cur[i][e];
            wht8(t);
#pragma unroll
            for (int i = 0; i < 8; ++i) { const float pr = dpp_mov<DPP_MIRROR>(dpp_mov<DPP_HMIRROR>(t[i])); const float v1 = __builtin_fmaf(t[i], sg2, pr);
                const unsigned own = __float_as_uint(v1); const auto sw = __builtin_amdgcn_permlane16_swap(own, own, false, false); const float p16 = __uint_as_float(sw[0] == own ? sw[1] : sw[0]);
                m[e] = fmaxf(m[e], fabsf(__builtin_fmaf(v1, sg4, p16))); } }
        if (more) {
#pragma unroll
            for (int i = 0; i < 8; ++i) cur[i] = nxt[i]; } }
#pragma unroll
    for (int e = 0; e < 4; ++e) { float x = m[e] * 0.03125f; x = fmaxf(x, dpp_mov<DPP_MIRROR>(dpp_mov<DPP_HMIRROR>(x))); m[e] = rows_max(x); }
    if (lane < 8) {
#pragma unroll
        for (int e = 0; e < 4; ++e) wsc[w_row(n0 + 4 * lane + e, rowoff, mode)] = m[e] * (1.f / 127.f); }
}
struct Job { const float* src; int K, N, klo, khi; bf16* dst; int pitch, rowoff, mode, range, i8, rot; float* wsc; float* part; };
constexpr int NJOBS = 24;
DI Job get_job(int j, ArgsP ap) {
    unsigned char* ws = ap->ws; Job b; b.klo = 0; b.mode = 0; b.range = 0; b.rowoff = 0; b.i8 = 0; b.rot = 0; b.wsc = nullptr; b.part = nullptr; float* WSC = (float*)(ws + WS_WSC);
    bf16* WB0 = (bf16*)(ws + WS_WB0); bf16* WL2 = (bf16*)(ws + WS_WL2);
    if (j < 3) { b.src = ap->in[7] + (size_t)j * D * D; b.K = D; b.N = D; b.dst = WB0; b.pitch = D; b.rowoff = D * j; }
    else if (j < 5) { const int d = j - 3; b.src = ap->in[9] + (size_t)d * D * 96; b.K = D; b.N = 96; b.dst = WB0; b.pitch = D; b.rowoff = 6144 + 96 * d; }
    else if (j < 7) { const int d = j - 5; b.src = ap->in[12] + (size_t)d * D * 96; b.K = D; b.N = 96; b.dst = WB0; b.pitch = D; b.rowoff = 6144 + 256 + 96 * d; }
    else if (j == 7) { b.src = ap->in[14]; b.K = D; b.N = 256; b.dst = WB0; b.pitch = D; b.rowoff = 6144 + 512; }
    else if (j < 10) { const int d = j - 8; b.src = ap->in[10] + (size_t)d * 96 * D; b.K = 256; b.N = D; b.klo = 96 * d; b.range = 1; b.dst = WL2 + (size_t)d * D * 256; b.pitch = 256; }
    else if (j < 12) { const int d = j - 10; b.src = ap->in[13] + (size_t)d * 96 * D; b.K = 256; b.N = D; b.klo = 96 * d; b.range = 1; b.dst = WL2 + (size_t)(2 + d) * D * 256; b.pitch = 256; }
    else if (j == 12) { b.src = ap->in[15]; b.K = 256; b.N = D; b.dst = WL2 + (size_t)4 * D * 256; b.pitch = 256; }
    else if (j == 13) { b.src = ap->in[21]; b.K = D; b.N = D; b.dst = (bf16*)(ws + WS_WO0); b.pitch = D; }
    else if (j == 14) { b.src = ap->in[22]; b.K = D; b.N = NQKV; b.dst = (bf16*)(ws + WS_WQKV); b.pitch = D; b.i8 = 1; b.wsc = WSC + WSC_QKV; }
    else if (j == 15) { b.src = ap->in[23]; b.K = D; b.N = D; b.dst = (bf16*)(ws + WS_WO1); b.pitch = D; b.i8 = 1; b.wsc = WSC + WSC_WO + D; }
    else if (j < 18) { const int l = j - 16; b.src = ap->in[24] + (size_t)l * D * 2 * FF; b.K = D; b.N = 2 * FF; b.dst = (bf16*)(ws + WS_WGU) + (size_t)l * FF * D  ; b.pitch = D; b.mode = 1; b.i8 = 1; b.wsc = WSC + WSC_GU + l * 2 * FF; }
    else if (j < 20) { const int l = j - 18; b.src = ap->in[25] + (size_t)l * FF * D; b.K = FF; b.N = D; b.dst = (bf16*)(ws + WS_WDN) + (size_t)l * D * FF; b.pitch = FF; b.i8 = 1; b.rot = 1; b.wsc = WSC + WSC_DN + (l ? 0 : 2048); b.part = WSC + WSC_DN + 4096 + (l ? 0 : 8192); }
    else if (j < 22) { const int l = j - 20; b.src = ap->in[27] + (size_t)l * D * D; b.K = D; b.N = D; b.dst = (bf16*)(ws + WS_WPG) + (size_t)l * D * D / 2  ; b.pitch = D; b.i8 = 1; b.wsc = WSC + WSC_PG + l * D; }
    else { const int l = j - 22; b.src = ap->in[28] + (size_t)l * PLE * D; b.K = PLE; b.N = D; b.dst = (bf16*)(ws + WS_WPP) + (size_t)l * D * PLE; b.pitch = PLE; }
    b.khi = b.range ? b.klo + 96 : b.K;
    return b;
}
DI int t5_bucket(int rel) {
    const int ret = rel > 0 ? 16 : 0; const int n = rel < 0 ? -rel : rel;
    if (n < 8) return ret + n;
    int large = 8 + (int)(logf((float)n / 8.f) / logf(128.f) * 8.f); large = large < 15 ? large : 15;
    return ret + large;
}
DI int job_order(int i) { return i < 4 ? 14 + i : (i < 6 ? 16 + i : (i == 6 ? 19 : (i == 7 ? 18 : (i < 22 ? i - 8 : i)))); }
DI void p0_scales(const Frame& F) {
    int base = 0;
    for (int i = 7; i >= 0; --i) {
        const Job b = get_job(job_order(i), args_ptr());
        if (!b.i8) continue;
        const int ns = b.rot ? (b.N >> 5) * 4 : (b.N >> 5); int g0 = F.gw - base % F.NGW; g0 += g0 < 0 ? F.NGW : 0;
        if (b.rot) { for (int it = g0; it < ns; it += F.NGW) col_absmax_strip_rot(b.src, b.K >> 2, b.N, b.rowoff, b.mode, b.part + (it & 3) * 2048, it >> 2, F.lane, (it & 3) * (b.K >> 2)); }
        else for (int st = g0; st < ns; st += F.NGW) col_absmax_strip(b.src, b.K, b.N, b.rowoff, b.mode, b.wsc, st, F.lane);
        base += ns;
    }
}
DI void p0_prologue(const Frame& F) {
    LAS float* scr = (LAS float*)(F.lds + F.wave * 9216);
    int base = 0;
    for (int i = 0; i < NJOBS; ++i) {
        const Job b = get_job(job_order(i), args_ptr());
        int g0 = F.gw - base % F.NGW; g0 += g0 < 0 ? F.NGW : 0;
        if (b.i8) tr_job<false, true>(b.src, b.K, b.N, b.klo, b.khi, b.dst, b.pitch, b.rowoff, b.mode, b.wsc, scr, g0, F.NGW, F.lane, b.rot, b.part, b.wsc);
        else if (b.range) tr_job<true, false>(b.src, b.K, b.N, b.klo, b.khi, b.dst, b.pitch, b.rowoff, b.mode, b.wsc, scr, g0, F.NGW, F.lane);
        else tr_job<false, false>(b.src, b.K, b.N, b.klo, b.khi, b.dst, b.pitch, b.rowoff, b.mode, b.wsc, scr, g0, F.NGW, F.lane);
        base += (b.K >> 6) * (b.N >> 5);
    }
    { ArgsP ap = args_ptr(); bf16* WB0 = (bf16*)(ap->ws + WS_WB0); const int gt = F.vcu * 512 + F.tid, NT = F.G * 512;
      for (int i = gt; i < 2 * 64 * D / 8; i += NT) { const int blk = i / (64 * D / 8), r = i % (64 * D / 8); *(u32x4*)(WB0 + (size_t)(6144 + 256 * blk + 192) * D + (size_t)r * 8) = (u32x4){0u, 0u, 0u, 0u}; }
      float* bt = (float*)(ap->ws + WS_BIAS); const float* tab = ap->in[5];
      for (int i = gt; i < 3 * 16 * 129; i += NT) { const int o = i % 129 - 64, gh = i / 129, gi = gh >> 4; const int dil = gi == 0 ? 1 : (gi == 1 ? 4 : 16);
          bt[i] = tab[t5_bucket(dil * o) * 48 + gh]; } }
}

DI void phase_mix(const Frame& F, const float* x, int Tseq, const float* g, const float* mu, bf16* xs) {
    for (int blk = F.gw; blk < S / 8; blk += F.NGW) {
        const int t0 = blk * 8;
        const bool has_prev = (t0 % Tseq) != 0, has_next = ((t0 + 8) % Tseq) != 0;
        float rs[10];
#pragma unroll
        for (int i = 0; i < 10; ++i) {
            int t = t0 - 1 + i; const bool ok = (i == 0) ? has_prev : ((i == 9) ? has_next : true); t = ok ? t : t0;
            const f32x4* xr = (const f32x4*)(x + (size_t)t * D) + F.lane; float s = 0.f;
#pragma unroll
            for (int jj = 0; jj < 8; ++jj) { const f32x4 v = xr[64 * jj]; s += (v.x * v.x + v.y * v.y) + (v.z * v.z + v.w * v.w); }
            s = wave_sum(s); rs[i] = ok ? rsqrt_fast(s * (1.f / D) + NORM_EPS) : 0.f;
        }
        const int tp = has_prev ? t0 - 1 : t0, tn = has_next ? t0 + 8 : t0;
#pragma unroll 1
        for (int jj = 0; jj < 8; ++jj) {
            const int col = 256 * jj + 4 * F.lane;
            const f32x4 g4 = *(const f32x4*)(g + col);
            f32x4 m4[6];
#pragma unroll
            for (int j = 0; j < 6; ++j) m4[j] = *(const f32x4*)(mu + j * D + col);
            f32x4 hp = *(const f32x4*)(x + (size_t)tp * D + col) * rs[0] * g4;
            f32x4 hc = *(const f32x4*)(x + (size_t)t0 * D + col) * rs[1] * g4;
#pragma unroll
            for (int i = 0; i < 8; ++i) {
                const int tt = (i == 7) ? tn : t0 + i + 1;
                const f32x4 hn = *(const f32x4*)(x + (size_t)tt * D + col) * rs[i + 2] * g4;
                const f32x4 xx = (hp + hn) * 0.5f - hc;
#pragma unroll
                for (int j = 0; j < 6; ++j) { const f32x4 o = hc + xx * m4[j]; u32x2 w; w.x = cvt_pk_bf16(o.x, o.y); w.y = cvt_pk_bf16(o.z, o.w);
                    *(u32x2*)(xs + (size_t)j * SLOT_ELEMS + (size_t)(t0 + i) * D + col) = w; }
                hp = hc; hc = hn;
            }
        }
    }
}
template <bool HAS_O, bool XF32> DI void phase_resnorm(const Frame& F, const void* xold_, bf16* xnew, const bf16* o, const float* ga, const float* gb, unsigned char* hout, float* asc, const float* p, bf16* pb) {
    for (int row = F.gw; row < S; row += F.NGW) {
        f32x4 xv[8];
#pragma unroll
        for (int jj = 0; jj < 4; ++jj) {
            if (XF32) { const f32x4* xr = (const f32x4*)((const float*)xold_ + (size_t)row * D + 512 * jj + 8 * F.lane); xv[2 * jj] = xr[0]; xv[2 * jj + 1] = xr[1]; }
            else { const u32x4 w = *(const u32x4*)((const bf16*)xold_ + (size_t)row * D + 512 * jj + 8 * F.lane);
                xv[2 * jj] = (f32x4){bflo(w.x), bfhi(w.x), bflo(w.y), bfhi(w.y)}; xv[2 * jj + 1] = (f32x4){bflo(w.z), bfhi(w.z), bflo(w.w), bfhi(w.w)}; } }
        if (HAS_O) {
            float ov[32]; float s = 0.f;
#pragma unroll
            for (int jj = 0; jj < 4; ++jj) { const u32x4 w = *(const u32x4*)(o + (size_t)row * D + 512 * jj + 8 * F.lane);
                ov[8 * jj + 0] = bflo(w.x); ov[8 * jj + 1] = bfhi(w.x); ov[8 * jj + 2] = bflo(w.y); ov[8 * jj + 3] = bfhi(w.y); ov[8 * jj + 4] = bflo(w.z); ov[8 * jj + 5] = bfhi(w.z); ov[8 * jj + 6] = bflo(w.w); ov[8 * jj + 7] = bfhi(w.w); }
#pragma unroll
            for (int e = 0; e < 32; ++e) s += ov[e] * ov[e];
            s = wave_sum(s); const float rstd = rsqrt_fast(s * (1.f / D) + NORM_EPS);
#pragma unroll
            for (int jj = 0; jj < 4; ++jj) { const f32x4* gr = (const f32x4*)(ga + 512 * jj + 8 * F.lane); const f32x4 g0 = gr[0], g1 = gr[1];
#pragma unroll
                for (int e = 0; e < 4; ++e) { xv[2 * jj][e] += ov[8 * jj + e] * rstd * g0[e]; xv[2 * jj + 1][e] += ov[8 * jj + 4 + e] * rstd * g1[e]; } }
#pragma unroll
            for (int jj = 0; jj < 4; ++jj) { u32x4 w; w.x = cvt_pk_bf16(xv[2 * jj].x, xv[2 * jj].y); w.y = cvt_pk_bf16(xv[2 * jj].z, xv[2 * jj].w); w.z = cvt_pk_bf16(xv[2 * jj + 1].x, xv[2 * jj + 1].y); w.w = cvt_pk_bf16(xv[2 * jj + 1].z, xv[2 * jj + 1].w);
                *(u32x4*)(xnew + (size_t)row * D + 512 * jj + 8 * F.lane) = w; }
        }
        float s2 = 0.f;
#pragma unroll
        for (int q = 0; q < 8; ++q) s2 += (xv[q].x * xv[q].x + xv[q].y * xv[q].y) + (xv[q].z * xv[q].z + xv[q].w * xv[q].w);
        s2 = wave_sum(s2); const float rstd2 = rsqrt_fast(s2 * (1.f / D) + NORM_EPS);
        float mx = 0.f;
#pragma unroll
        for (int jj = 0; jj < 4; ++jj) { const f32x4* gr = (const f32x4*)(gb + 512 * jj + 8 * F.lane); xv[2 * jj] = xv[2 * jj] * rstd2 * gr[0]; xv[2 * jj + 1] = xv[2 * jj + 1] * rstd2 * gr[1];
#pragma unroll
            for (int e = 0; e < 4; ++e) mx = fmaxf(mx, fmaxf(fabsf(xv[2 * jj][e]), fabsf(xv[2 * jj + 1][e]))); }
        mx = wave_max(mx); const float inv = mx > 0.f ? 127.f / mx : 0.f;
#pragma unroll
        for (int jj = 0; jj < 4; ++jj) { const f32x4 a = xv[2 * jj] * inv, b = xv[2 * jj + 1] * inv; u32x2 w; w.x = pack4_i8(a.x, a.y, a.z, a.w); w.y = pack4_i8(b.x, b.y, b.z, b.w);
            *(u32x2*)(hout + (size_t)row * D + 512 * jj + 8 * F.lane) = w; }
        if (F.lane == 0) asc[row] = mx * (1.f / 127.f);
        if (p) { const f32x4 pv = *(const f32x4*)(p + (size_t)row * PLE + 4 * F.lane); u32x2 w; w.x = cvt_pk_bf16(pv.x, pv.y); w.y = cvt_pk_bf16(pv.z, pv.w); *(u32x2*)(pb + (size_t)row * PLE + 4 * F.lane) = w; }
    }
}
DI void unpack8(const u32x4 w, float (&f)[8]) { f[0] = bflo(w.x); f[1] = bfhi(w.x); f[2] = bflo(w.y); f[3] = bfhi(w.y); f[4] = bflo(w.z); f[5] = bfhi(w.z); f[6] = bflo(w.w); f[7] = bfhi(w.w); }
DI void phase_quant_hidden(const Frame& F, const bf16* hid, unsigned char* out, float* asc) {
    const float sg2 = (F.lane & 1) ? -1.f : 1.f, sg4 = (F.lane & 2) ? -1.f : 1.f;
    for (int row = F.gw; row < S; row += F.NGW) {
        u32x4 w[11]; float tf[11][8]; float mx = 0.f;
#pragma unroll
        for (int c = 0; c < 11; ++c) w[c] = *(const u32x4*)(hid + (size_t)row * FF + (c * 64 + F.lane) * 8);
#pragma unroll
        for (int c = 0; c < 11; ++c) { float f[8]; unpack8(w[c], f); wht8(f);
#pragma unroll
            for (int e = 0; e < 8; ++e) { float x = __builtin_fmaf(f[e], sg2, dpp_mov<DPP_XOR1>(f[e])); x = __builtin_fmaf(x, sg4, dpp_mov<DPP_XOR2>(x)); tf[c][e] = x; mx = fmaxf(mx, fabsf(x)); } }
        mx = wave_max(mx); const float inv = mx > 0.f ? 127.f / mx : 0.f;
#pragma unroll
        for (int c = 0; c < 11; ++c) { u32x2 o; o.x = pack4_i8(tf[c][0] * inv, tf[c][1] * inv, tf[c][2] * inv, tf[c][3] * inv); o.y = pack4_i8(tf[c][4] * inv, tf[c][5] * inv, tf[c][6] * inv, tf[c][7] * inv);
            *(u32x2*)(out + (size_t)row * FF + (c * 64 + F.lane) * 8) = o; }
        if (F.lane == 0) asc[row] = mx * (1.f / 127.f);
    }
}
DI void phase_post(const Frame& F, const bf16* y0, const bf16* y1, const bf16* v, const bf16* g, const float* BON, const float* lnx_g, const float* lnx_b, bf16* out) {
    for (int row = F.gw; row < S; row += F.NGW) {
#pragma unroll 1
        for (int jj = 0; jj < 4; ++jj) {
            const size_t e0 = (size_t)row * D + 512 * jj + 8 * F.lane; const int c0 = 512 * jj + 8 * F.lane;
            float fy0[8], fy1[8], fv[8], fg[8];
            unpack8(*(const u32x4*)(y0 + e0), fy0); unpack8(*(const u32x4*)(y1 + e0), fy1); unpack8(*(const u32x4*)(v + e0), fv); unpack8(*(const u32x4*)(g + e0), fg);
            const float bs = 0.5f * (BON[(size_t)row * 32 + (c0 >> 6)] + BON[(size_t)S * 32 + (size_t)row * 32 + (c0 >> 6)]);
            float lg[8], lb[8];
            *(f32x4*)&lg[0] = *(const f32x4*)(lnx_g + c0); *(f32x4*)&lg[4] = *(const f32x4*)(lnx_g + c0 + 4); *(f32x4*)&lb[0] = *(const f32x4*)(lnx_b + c0); *(f32x4*)&lb[4] = *(const f32x4*)(lnx_b + c0 + 4);
            float y[8], s = 0.f;
#pragma unroll
            for (int e = 0; e < 8; ++e) { y[e] = fy0[e] + fy1[e]; s += y[e]; }
            s = oct_sum(s);
            const float mean = s * (1.f / 64.f); float q = 0.f;
#pragma unroll
            for (int e = 0; e < 8; ++e) { y[e] -= mean; q += y[e] * y[e]; }
            q = oct_sum(q);
            const float rstd = rsqrt_fast(q * (1.f / 64.f) + GN_EPS);
            float o[8];
#pragma unroll
            for (int e = 0; e < 8; ++e) o[e] = (y[e] * rstd * lg[e] + lb[e] + bs * fv[e]) * fg[e];
            u32x4 w; w.x = cvt_pk_bf16(o[0], o[1]); w.y = cvt_pk_bf16(o[2], o[3]); w.z = cvt_pk_bf16(o[4], o[5]); w.w = cvt_pk_bf16(o[6], o[7]);
            *(u32x4*)(out + e0) = w;
        }
    }
}
constexpr int WK_A = 0, WK_R = 4608, WK_B = 9216, WK_K = 13824, WK_BH = 18432, WK_KH = 23552, WK_VT = 28672,
              WK_TT = 33792, WK_AAK = 36352, WK_ARB = 38912, WK_ARK = 41472, WK_A10 = 44032  ,
              WK_RAW = 44544  , WK_GROUP = 65536,
              WK_SMALL = 131072 + 1024  ;
constexpr int ST64 = 144, ST32 = 80;
DI bf16x8 frag_nat(const LAS unsigned char* p) { return *(const LAS bf16x8*)p; }
DI bf16x8 frag_perm(const LAS unsigned char* p) { const s16x4 lo = *(const LAS s16x4*)p, hi = *(const LAS s16x4*)(p + 32); return (bf16x8){lo[0], lo[1], lo[2], lo[3], hi[0], hi[1], hi[2], hi[3]}; }
DI bf16x8 pack_acc(const f32x4& a, const f32x4& b) { u32x4 w; w.x = cvt_pk_bf16(a[0], a[1]); w.y = cvt_pk_bf16(a[2], a[3]); w.z = cvt_pk_bf16(b[0], b[1]); w.w = cvt_pk_bf16(b[2], b[3]); return __builtin_bit_cast(bf16x8, w); }
#define MFMA16(a, b, c) __builtin_amdgcn_mfma_f32_16x16x32_bf16((a), (b), (c), 0, 0, 0)

template <int MODE> DI void phase_wkv(const Frame& F, int nseq, const bf16* R, const bf16* K, const bf16* V, const bf16* LW, const float* k_k, const float* k_a, const float* r_k, bf16* Y, float* PT, bf16* MB, float* BON) {
    const int lane = F.lane, l15 = lane & 15, g = lane >> 4, wq = F.wave & 3, grp = F.wave >> 2, tg = F.tid & 255;
    const int Tseq = S / nseq;
    LAS unsigned char* gb = F.lds + grp * WK_GROUP;
    LAS float* CWP = (LAS float*)(F.lds + WK_SMALL + grp * 1280); LAS float* WC = CWP + 256;
    const f32x4 zero4 = (f32x4){0.f, 0.f, 0.f, 0.f};
    for (int task = F.vcu * 2 + grp; task < 512; task += F.G * 2) {
        int seq, head, dir, seg;
        if (nseq == 8) { seq = task >> 6; head = (task >> 1) & 31; dir = task & 1; seg = 0; }
        else { const int chain = task >> 3; seq = 0; head = chain >> 1; dir = chain & 1; seg = task & 7; }
        const size_t seqbase = (size_t)seq * Tseq;
        const bf16* lwp = LW + (size_t)dir * SLOT_ELEMS; const bf16* alp = LW + (size_t)(2 + dir) * SLOT_ELEMS; bf16* yo = Y + (size_t)dir * SLOT_ELEMS;
        const int hc = head * 64;
        const float kkw = k_k[hc + lane], kaw = k_a[hc + lane], rkw = r_k[hc + lane];
        float* bon = BON + (size_t)dir * S * 32 + head;
        f32x4 st[4], sid[4];
#pragma unroll
        for (int m = 0; m < 4; ++m) { st[m] = zero4;
#pragma unroll
            for (int e = 0; e < 4; ++e) sid[m][e] = (16 * m + 4 * g + e == 16 * wq + l15) ? 1.f : 0.f; }
        if (MODE == 0 && seg > 0) {
            for (int j = 0; j < seg; ++j) {
                const float* Pi = PT + (size_t)((task & ~7) + j) * 8192; const float* Th = Pi + 4096;
                bf16x8 sf[2]; sf[0] = pack_acc(st[0], st[1]); sf[1] = pack_acc(st[2], st[3]);
#pragma unroll
                for (int m = 0; m < 4; ++m) { f32x4 nw;
#pragma unroll
                    for (int e = 0; e < 4; ++e) nw[e] = Th[(16 * m + 4 * g + e) * 64 + 16 * wq + l15];
#pragma unroll
                    for (int ks = 0; ks < 2; ++ks) { const float* pr = Pi + (16 * m + l15) * 64 + 32 * ks + 4 * g; const f32x4 lo = *(const f32x4*)pr, hi = *(const f32x4*)(pr + 16);
                        nw = MFMA16(pack_acc(lo, hi), sf[ks], nw); }
                    st[m] = nw; }
            }
        }
        u32x4 raw[5];
#define WK_LOAD(ch) do { const int sg = seg * 2048 + (ch) * 32 + (tg >> 3), t = dir ? Tseq - 1 - sg : sg; const size_t el = (seqbase + t) * D + hc + 8 * (tg & 7); \
            raw[0] = *(const u32x4*)(R + el); raw[1] = *(const u32x4*)(K + el); raw[2] = *(const u32x4*)(V + el); raw[3] = *(const u32x4*)(lwp + el); raw[4] = *(const u32x4*)(alp + el); } while (0)
        WK_LOAD(0);
#pragma unroll
        for (int x = 0; x < 5; ++x) *(LAS u32x4*)(gb + WK_RAW + x * 4096 + tg * 16) = raw[x];
        WK_LOAD(1);
        __syncthreads();
#pragma unroll 1
        for (int ch = 0; ch < 64; ++ch) {
            int ln_ = F.lane; if (MODE != 0) asm volatile("" : "+v"(ln_)); const int lane = ln_, l15 = ln_ & 15, g = ln_ >> 4; const int tg = (F.tid & 192) | ln_;
            unsigned short r8[8], k8[8], v8[8], w8[8], a8[8];
            {
              LAS unsigned char* rp = gb + WK_RAW + (8 * wq + ((lane >> 2) & 3)) * 128 + ((lane >> 4) * 16 + (lane & 3) * 4) * 2;
#define WK_TR(dst, x) do { const s16x4 lo_ = __builtin_amdgcn_ds_read_tr16_b64_v4i16((LAS s16x4*)(rp + (x) * 4096)), hi_ = __builtin_amdgcn_ds_read_tr16_b64_v4i16((LAS s16x4*)(rp + (x) * 4096 + 512)); \
                  _Pragma("unroll") for (int q_ = 0; q_ < 4; ++q_) { dst[q_] = (unsigned short)lo_[q_]; dst[4 + q_] = (unsigned short)hi_[q_]; } } while (0)
              WK_TR(r8, 0); WK_TR(k8, 1); WK_TR(v8, 2); WK_TR(w8, 3); WK_TR(a8, 4);
#undef WK_TR
            }
            float lwf[8], cl[8]; float run = 0.f;
#pragma unroll
            for (int e = 0; e < 8; ++e) { lwf[e] = bf2f(w8[e]); run += lwf[e]; cl[e] = run; }
            CWP[wq * 64 + lane] = run;
            __syncthreads();
            const float p0 = CWP[lane], p1 = CWP[64 + lane], p2 = CWP[128 + lane], p3 = CWP[192 + lane];
            const float cwC = (p0 + p1) + (p2 + p3);
            const float pre = (wq > 0 ? p0 : 0.f) + (wq > 1 ? p1 : 0.f) + (wq > 2 ? p2 : 0.f);
            if (ch + 1 < 64) {
#pragma unroll
                for (int x = 0; x < 5; ++x) *(LAS u32x4*)(gb + WK_RAW + x * 4096 + tg * 16) = raw[x]; }
            const float expC = __expf(cwC);
            float bh8[8], kh8[8], sq[8], bn[8]; float ePrev = __expf(pre);
#pragma unroll
            for (int e = 0; e < 8; ++e) { const float kkr = bf2f(k8[e]) * kkw; sq[e] = kkr * kkr; }
            const int ssw = __float_as_int(wave_sum8(sq, lane));
#pragma unroll
            for (int e = 0; e < 8; ++e) {
                const int s = 8 * wq + e; const float kf = bf2f(k8[e]), rf = bf2f(r8[e]), al = bf2f(a8[e]);
                const float kkr = kf * kkw; const float ss = __int_as_float(__builtin_amdgcn_readlane(ssw, bitrev3(e))); const float kk = kkr * rsqrt_fast(ss + 1e-12f);
                const float cw = pre + cl[e]; const float e1 = __expf(cw), e2 = __builtin_amdgcn_rcpf(e1), eC = expC * e2;
                const float kj = kf * (1.f + (al - 1.f) * kaw), kb = kk * al;
                *(LAS unsigned short*)(gb + WK_A + s * ST64 + lane * 2) = f2bf(-kk * ePrev); ePrev = e1;
                *(LAS unsigned short*)(gb + WK_R + s * ST64 + lane * 2) = f2bf(rf * e1);
                *(LAS unsigned short*)(gb + WK_B + s * ST64 + lane * 2) = f2bf(kb * e2);
                *(LAS unsigned short*)(gb + WK_K + s * ST64 + lane * 2) = f2bf(kj * e2);
                bh8[e] = kb * eC; kh8[e] = kj * eC;
                bn[e] = rf * kj * rkw;
            }
            { const float bsw = wave_sum8(bn, lane);
              if (lane < 8) { const int sg = seg * 2048 + ch * 32 + 8 * wq + (((lane & 1) << 2) | (lane & 2) | ((lane >> 2) & 1)), t = dir ? Tseq - 1 - sg : sg; bon[(seqbase + t) * 32] = bsw; } }
            { u32x4 w; w.x = cvt_pk_bf16(bh8[0], bh8[1]); w.y = cvt_pk_bf16(bh8[2], bh8[3]); w.z = cvt_pk_bf16(bh8[4], bh8[5]); w.w = cvt_pk_bf16(bh8[6], bh8[7]); *(LAS u32x4*)(gb + WK_BH + lane * ST32 + 16 * wq) = w;
              w.x = cvt_pk_bf16(kh8[0], kh8[1]); w.y = cvt_pk_bf16(kh8[2], kh8[3]); w.z = cvt_pk_bf16(kh8[4], kh8[5]); w.w = cvt_pk_bf16(kh8[6], kh8[7]); *(LAS u32x4*)(gb + WK_KH + lane * ST32 + 16 * wq) = w;
              w.x = (unsigned)v8[0] | ((unsigned)v8[1] << 16); w.y = (unsigned)v8[2] | ((unsigned)v8[3] << 16); w.z = (unsigned)v8[4] | ((unsigned)v8[5] << 16); w.w = (unsigned)v8[6] | ((unsigned)v8[7] << 16);
              *(LAS u32x4*)(gb + WK_VT + lane * ST32 + 16 * wq) = w; }
            if (wq == 0) WC[lane] = expC;
            if (ch + 2 < 64) WK_LOAD(ch + 2);
            __syncthreads();
            {
                const int mt = wq >> 1, nt = wq & 1;
                f32x4 ab = zero4, ak = zero4, rb = zero4, rk = zero4, abT = zero4;
                if (mt >= nt) {
                    const int arow = 16 * mt + l15, brow = 16 * nt + l15;
#pragma unroll
                    for (int ks = 0; ks < 2; ++ks) {
                        const bf16x8 af = frag_nat(gb + WK_A + arow * ST64 + 64 * ks + 16 * g), rf = frag_nat(gb + WK_R + arow * ST64 + 64 * ks + 16 * g);
                        const bf16x8 bf_ = frag_nat(gb + WK_B + brow * ST64 + 64 * ks + 16 * g), kf_ = frag_nat(gb + WK_K + brow * ST64 + 64 * ks + 16 * g);
                        ab = MFMA16(af, bf_, ab); ak = MFMA16(af, kf_, ak); rb = MFMA16(rf, bf_, rb); rk = MFMA16(rf, kf_, rk);
                        if (mt == nt) abT = MFMA16(bf_, af, abT);
                    }
                }
#pragma unroll
                for (int e = 0; e < 4; ++e) { const int s = 16 * mt + 4 * g + e, i = 16 * nt + l15; const bool lo = i < s, le = i <= s;
                    if (wq == 2) *(LAS unsigned short*)(gb + WK_A10 + (s - 16) * 32 + i * 2) = f2bf(ab[e]);
                    *(LAS unsigned short*)(gb + WK_AAK + s * ST32 + i * 2) = f2bf(lo ? ak[e] : 0.f);
                    *(LAS unsigned short*)(gb + WK_ARB + s * ST32 + i * 2) = f2bf(le ? rb[e] : 0.f);
                    *(LAS unsigned short*)(gb + WK_ARK + s * ST32 + i * 2) = f2bf(le ? rk[e] : 0.f); }
                if (mt == nt) {
                    f32x4 X, XT, PT;
#pragma unroll
                    for (int e = 0; e < 4; ++e) { const int rr = 4 * g + e; X[e] = l15 < rr ? ab[e] : 0.f; XT[e] = rr < l15 ? abT[e] : 0.f; PT[e] = XT[e] + (rr == l15 ? 1.f : 0.f); }
                    const bf16x8 xa = pack_acc(X, zero4), xt = pack_acc(XT, zero4);
                    const f32x4 X2 = MFMA16(xt, xa, zero4), X2T = MFMA16(xa, xt, zero4);
                    const bf16x8 x2 = pack_acc(X2, zero4), x2t = pack_acc(X2T, zero4);
                    PT = MFMA16(x2, pack_acc(PT, zero4), PT);
                    const f32x4 X4 = MFMA16(x2t, x2, zero4), X4T = MFMA16(x2, x2t, zero4);
                    const bf16x8 x4 = pack_acc(X4, zero4), x4t = pack_acc(X4T, zero4);
                    PT = MFMA16(x4, pack_acc(PT, zero4), PT);
                    const f32x4 X8 = MFMA16(x4t, x4, zero4);
                    PT = MFMA16(pack_acc(X8, zero4), pack_acc(PT, zero4), PT);
                    u32x2 w; w.x = cvt_pk_bf16(PT[0], PT[1]); w.y = cvt_pk_bf16(PT[2], PT[3]);
                    *(LAS u32x2*)(gb + WK_TT + (16 * mt + l15) * ST32 + (16 * mt + 4 * g) * 2) = w;
                }
            }
            __syncthreads();
            const bf16x8 vfr = frag_nat(gb + WK_VT + (16 * wq + l15) * ST32 + 16 * g);
            bf16x8 t00f, t11f, a10f;
            { const s16x4 q0 = *(const LAS s16x4*)(gb + WK_TT + l15 * ST32 + 8 * g), q1 = *(const LAS s16x4*)(gb + WK_TT + (16 + l15) * ST32 + (16 + 4 * g) * 2), q2 = *(const LAS s16x4*)(gb + WK_A10 + l15 * 32 + 8 * g);
              t00f = (bf16x8){q0[0], q0[1], q0[2], q0[3], 0, 0, 0, 0}; t11f = (bf16x8){q1[0], q1[1], q1[2], q1[3], 0, 0, 0, 0}; a10f = (bf16x8){q2[0], q2[1], q2[2], q2[3], 0, 0, 0, 0}; }
            if (MODE == 0) {
                bf16x8 sf[2]; sf[0] = pack_acc(st[0], st[1]); sf[1] = pack_acc(st[2], st[3]);
                f32x4 z[2], u[2], y[2];
#pragma unroll
                for (int mt = 0; mt < 2; ++mt) { const int row = 16 * mt + l15;
                    z[mt] = MFMA16(frag_perm(gb + WK_A + row * ST64 + 8 * g), sf[0], zero4); z[mt] = MFMA16(frag_perm(gb + WK_A + row * ST64 + 64 + 8 * g), sf[1], z[mt]);
                    z[mt] = MFMA16(frag_nat(gb + WK_AAK + row * ST32 + 16 * g), vfr, z[mt]); }
                u[0] = MFMA16(t00f, pack_acc(z[0], zero4), zero4);
                z[1] = MFMA16(a10f, pack_acc(u[0], zero4), z[1]);
                u[1] = MFMA16(t11f, pack_acc(z[1], zero4), zero4);
                const bf16x8 uf = pack_acc(u[0], u[1]);
#pragma unroll
                for (int mt = 0; mt < 2; ++mt) { const int row = 16 * mt + l15;
                    y[mt] = MFMA16(frag_perm(gb + WK_R + row * ST64 + 8 * g), sf[0], zero4); y[mt] = MFMA16(frag_perm(gb + WK_R + row * ST64 + 64 + 8 * g), sf[1], y[mt]);
                    y[mt] = MFMA16(frag_perm(gb + WK_ARB + row * ST32 + 8 * g), uf, y[mt]); y[mt] = MFMA16(frag_nat(gb + WK_ARK + row * ST32 + 16 * g), vfr, y[mt]); }
#pragma unroll
                for (int m = 0; m < 4; ++m) { const int crow = 16 * m + l15; const f32x4 wc4 = *(const LAS f32x4*)(WC + 16 * m + 4 * g);
                    st[m] = st[m] * wc4; st[m] = MFMA16(frag_perm(gb + WK_BH + crow * ST32 + 8 * g), uf, st[m]); st[m] = MFMA16(frag_nat(gb + WK_KH + crow * ST32 + 16 * g), vfr, st[m]); }
#pragma unroll
                for (int mt = 0; mt < 2; ++mt)
#pragma unroll
                    for (int e = 0; e < 4; ++e) { const int sg = seg * 2048 + ch * 32 + 16 * mt + 4 * g + e, t = dir ? Tseq - 1 - sg : sg;
                        yo[(seqbase + t) * D + hc + 16 * wq + l15] = f2bf(y[mt][e]); }
            } else {
                bf16x8 sf[2], sfi[2]; sf[0] = pack_acc(st[0], st[1]); sf[1] = pack_acc(st[2], st[3]); sfi[0] = pack_acc(sid[0], sid[1]); sfi[1] = pack_acc(sid[2], sid[3]);
                f32x4 z[2], zi[2], u[2], ui[2];
#pragma unroll
                for (int mt = 0; mt < 2; ++mt) { const int row = 16 * mt + l15; const bf16x8 a0 = frag_perm(gb + WK_A + row * ST64 + 8 * g), a1 = frag_perm(gb + WK_A + row * ST64 + 64 + 8 * g);
                    z[mt] = MFMA16(a0, sf[0], zero4); z[mt] = MFMA16(a1, sf[1], z[mt]); z[mt] = MFMA16(frag_nat(gb + WK_AAK + row * ST32 + 16 * g), vfr, z[mt]);
                    zi[mt] = MFMA16(a0, sfi[0], zero4); zi[mt] = MFMA16(a1, sfi[1], zi[mt]); }
                u[0] = MFMA16(t00f, pack_acc(z[0], zero4), zero4); ui[0] = MFMA16(t00f, pack_acc(zi[0], zero4), zero4);
                z[1] = MFMA16(a10f, pack_acc(u[0], zero4), z[1]); zi[1] = MFMA16(a10f, pack_acc(ui[0], zero4), zi[1]);
                u[1] = MFMA16(t11f, pack_acc(z[1], zero4), zero4); ui[1] = MFMA16(t11f, pack_acc(zi[1], zero4), zero4);
                const bf16x8 uf = pack_acc(u[0], u[1]), ufi = pack_acc(ui[0], ui[1]);
                __builtin_amdgcn_sched_barrier(0);
                bf16* mb = MB + ((size_t)task * 64 + ch) * 2048;
#pragma unroll
                for (int mt = 0; mt < 2; ++mt) { const int row = 16 * mt + l15; const bf16x8 r0 = frag_perm(gb + WK_R + row * ST64 + 8 * g), r1 = frag_perm(gb + WK_R + row * ST64 + 64 + 8 * g), rbf = frag_perm(gb + WK_ARB + row * ST32 + 8 * g);
                    f32x4 y = MFMA16(r0, sf[0], zero4); y = MFMA16(r1, sf[1], y); y = MFMA16(rbf, uf, y); y = MFMA16(frag_nat(gb + WK_ARK + row * ST32 + 16 * g), vfr, y);
                    f32x4 yi = MFMA16(r0, sfi[0], zero4); yi = MFMA16(r1, sfi[1], yi); yi = MFMA16(rbf, ufi, yi);
#pragma unroll
                    for (int e = 0; e < 4; ++e) { const int s = 16 * mt + 4 * g + e, sg = seg * 2048 + ch * 32 + s, t = dir ? Tseq - 1 - sg : sg;
                        yo[(seqbase + t) * D + hc + 16 * wq + l15] = f2bf(y[e]); mb[s * 64 + 16 * wq + l15] = f2bf(yi[e]); } }
                __builtin_amdgcn_sched_barrier(0);
#pragma unroll
                for (int m = 0; m < 4; ++m) { const int crow = 16 * m + l15; const f32x4 wc4 = *(const LAS f32x4*)(WC + 16 * m + 4 * g); const bf16x8 bhf = frag_perm(gb + WK_BH + crow * ST32 + 8 * g);
                    st[m] = st[m] * wc4; st[m] = MFMA16(bhf, uf, st[m]); st[m] = MFMA16(frag_nat(gb + WK_KH + crow * ST32 + 16 * g), vfr, st[m]);
                    sid[m] = sid[m] * wc4; sid[m] = MFMA16(bhf, ufi, sid[m]); }
            }
        }
#undef WK_LOAD
        if (MODE == 1 && seg < 7) {
            float* Pi = PT + (size_t)task * 8192; float* Th = Pi + 4096;
#pragma unroll
            for (int m = 0; m < 4; ++m)
#pragma unroll
                for (int e = 0; e < 4; ++e) { const int o = (16 * m + 4 * g + e) * 64 + 16 * wq + l15; Pi[o] = sid[m][e]; Th[o] = st[m][e]; }
        }
    }
}

DI void phase_wkv_fix(const Frame& F, const float* PT, const bf16* MB, bf16* Y) {
    const int lane = F.lane, l15 = lane & 15, g = lane >> 4, wq = F.wave & 3, grp = F.wave >> 2;
    const int Tseq = S;
    const f32x4 zero4 = (f32x4){0.f, 0.f, 0.f, 0.f};
    for (int task = F.vcu * 2 + grp; task < 512; task += F.G * 2) {
        const int chain = task >> 3, head = chain >> 1, dir = chain & 1, seg = task & 7;
        if (seg == 0) continue;
        f32x4 st[4];
#pragma unroll
        for (int m = 0; m < 4; ++m) st[m] = zero4;
        for (int j = 0; j < seg; ++j) {
            const float* Pi = PT + (size_t)((task & ~7) + j) * 8192; const float* Th = Pi + 4096;
            bf16x8 sf[2]; sf[0] = pack_acc(st[0], st[1]); sf[1] = pack_acc(st[2], st[3]);
#pragma unroll
            for (int m = 0; m < 4; ++m) { f32x4 nw;
#pragma unroll
                for (int e = 0; e < 4; ++e) nw[e] = Th[(16 * m + 4 * g + e) * 64 + 16 * wq + l15];
#pragma unroll
                for (int ks = 0; ks < 2; ++ks) { const float* pr = Pi + (16 * m + l15) * 64 + 32 * ks + 4 * g; const f32x4 lo = *(const f32x4*)pr, hi = *(const f32x4*)(pr + 16);
                    nw = MFMA16(pack_acc(lo, hi), sf[ks], nw); }
                st[m] = nw; }
        }
        bf16x8 sf[2]; sf[0] = pack_acc(st[0], st[1]); sf[1] = pack_acc(st[2], st[3]);
        bf16* yo = Y + (size_t)dir * SLOT_ELEMS; const int hc = head * 64;
        u32x2 mlo[2][2][2], mhi[2][2][2]; unsigned short yv[2][2][4];
#define FIX_LOAD(c_) do { _Pragma("unroll") for (int q = 0; q < 2; ++q) { const bf16* mb = MB + ((size_t)task * 64 + (c_) + q) * 2048; \
            _Pragma("unroll") for (int mt = 0; mt < 2; ++mt) { const bf16* mr = mb + (16 * mt + l15) * 64 + 4 * g; \
                _Pragma("unroll") for (int ks = 0; ks < 2; ++ks) { mlo[q][mt][ks] = *(const u32x2*)(mr + 32 * ks); mhi[q][mt][ks] = *(const u32x2*)(mr + 32 * ks + 16); } \
                _Pragma("unroll") for (int e = 0; e < 4; ++e) { const int sg = seg * 2048 + ((c_) + q) * 32 + 16 * mt + 4 * g + e, t = dir ? Tseq - 1 - sg : sg; yv[q][mt][e] = yo[(size_t)t * D + hc + 16 * wq + l15]; } } } } while (0)
        FIX_LOAD(0);
#pragma unroll 1
        for (int c2 = 0; c2 < 64; c2 += 2) {
            f32x4 acc[2][2]; float yf[2][2][4];
#pragma unroll
            for (int q = 0; q < 2; ++q)
#pragma unroll
                for (int mt = 0; mt < 2; ++mt) { acc[q][mt] = zero4;
#pragma unroll
                    for (int ks = 0; ks < 2; ++ks) { const u32x4 w = (u32x4){mlo[q][mt][ks].x, mlo[q][mt][ks].y, mhi[q][mt][ks].x, mhi[q][mt][ks].y}; acc[q][mt] = MFMA16(__builtin_bit_cast(bf16x8, w), sf[ks], acc[q][mt]); }
#pragma unroll
                    for (int e = 0; e < 4; ++e) yf[q][mt][e] = bf2f(yv[q][mt][e]); }
            if (c2 + 2 < 64) FIX_LOAD(c2 + 2);
#pragma unroll
            for (int q = 0; q < 2; ++q)
#pragma unroll
                for (int mt = 0; mt < 2; ++mt)
#pragma unroll
                    for (int e = 0; e < 4; ++e) { const int sg = seg * 2048 + (c2 + q) * 32 + 16 * mt + 4 * g + e, t = dir ? Tseq - 1 - sg : sg; yo[(size_t)t * D + hc + 16 * wq + l15] = f2bf(yf[q][mt][e] + acc[q][mt][e]); }
        }
#undef FIX_LOAD
    }
}
DI unsigned v_off(unsigned row, unsigned ch) { return 256u * row + 16u * (ch ^ (((row & 3u) << 2) | ((row >> 2) & 3u))); }
DI bf16x8 tr_read2(unsigned a0, unsigned a1) {
    s16x4 lo, hi; asm volatile("ds_read_b64_tr_b16 %0, %2\n\tds_read_b64_tr_b16 %1, %3\n\ts_waitcnt lgkmcnt(0)" : "=&v"(lo), "=&v"(hi) : "v"(a0), "v"(a1) : "memory");
    return (bf16x8){lo[0], lo[1], lo[2], lo[3], hi[0], hi[1], hi[2], hi[3]};
}
constexpr int ATT_RING = 65536;
DI void tr_read4_nw(unsigned alo, unsigned ahi, s16x4 (&lo)[2], s16x4 (&hi)[2]) {
    asm volatile("ds_read_b64_tr_b16 %0, %4\n\tds_read_b64_tr_b16 %2, %5\n\tds_read_b64_tr_b16 %1, %4 offset:8192\n\tds_read_b64_tr_b16 %3, %5 offset:8192"
                 : "=&v"(lo[0]), "=&v"(lo[1]), "=&v"(hi[0]), "=&v"(hi[1]) : "v"(alo), "v"(ahi) : "memory");
}
DI void tr_wait12(s16x4 (&a)[2], s16x4 (&b)[2], s16x4 (&c)[2], s16x4 (&d)[2], s16x4 (&e)[2], s16x4 (&f)[2]) {
    asm volatile("s_waitcnt lgkmcnt(0)" : "+v"(a[0]), "+v"(a[1]), "+v"(b[0]), "+v"(b[1]), "+v"(c[0]), "+v"(c[1]), "+v"(d[0]), "+v"(d[1]), "+v"(e[0]), "+v"(e[1]), "+v"(f[0]), "+v"(f[1]) :: "memory");
}
struct AU { int gi, dil, NT, cls, up, run; size_t seqbase; };
DI AU au_decode(int k, int part, int Tseq) {
    AU a; a.gi = k >> 3; const int idx = 8 * part + (k & 7); a.dil = a.gi == 0 ? 1 : (a.gi == 1 ? 4 : 16); const int L = Tseq / a.dil; a.NT = L >> 6; const int upr = L >> 7;
    a.run = idx / upr; a.up = idx - a.run * upr; const int seq = a.run / a.dil; a.cls = a.run - seq * a.dil; a.seqbase = (size_t)seq * Tseq; return a;
}
DI void att_tiles_load(const bf16* QKV, const AU& a, int head, int t0, int tid, u32x4 (&kr)[4], u32x4 (&vr)[4]) {
    const int kcol = a.gi * 6144 + 2048 + head * 128;
#pragma unroll
    for (int i = 0; i < 4; ++i) { const int id = tid + 512 * i, tl = id >> 10, rem = id & 1023, r = rem >> 4, ch = rem & 15; int t = t0 + tl; t = t < 0 ? 0 : (t >= a.NT ? a.NT - 1 : t);
        const bf16* p = QKV + (a.seqbase + (size_t)(64 * t + r) * a.dil + a.cls) * NQKV + kcol + 8 * ch; kr[i] = *(const u32x4*)p; vr[i] = *(const u32x4*)(p + 2048); }
}
DI void att_tiles_store(LAS unsigned char* ring, int t0, int tid, const u32x4 (&kr)[4], const u32x4 (&vr)[4]) {
#pragma unroll
    for (int i = 0; i < 4; ++i) { const int id = tid + 512 * i, tl = id >> 10, rem = id & 1023, r = rem >> 4, ch = rem & 15; const unsigned o = v_off((unsigned)(((t0 + tl) & 3) * 64 + r), ch);
        *(LAS u32x4*)(ring + o) = kr[i]; *(LAS u32x4*)(ring + ATT_RING + o) = vr[i]; }
}
DI void phase_attn(const Frame& F, const bf16* QKV, int Tseq, const float* biastab, bf16* OG, float* LSE, const int gsel) {
    const int lane = F.lane, l15 = lane & 15, g = lane >> 4, blk = F.wave >> 2, wq = F.wave & 3, tid = F.tid;
    constexpr float LOG2E = 1.4426950408889634f, SCALE = 0.08838834764831845f * LOG2E;
    LAS unsigned char* ring = F.lds;
    const unsigned vbase = (unsigned)(uintptr_t)(F.ldsg + ATT_RING);
    const int qi = 16 * wq + l15;
    for (int vw = F.vcu; vw < 256; vw += F.G) {
        const int head = vw & 15, part = vw >> 4;
        unsigned biasp[6][2][2]; int gi_cur = -1;
        u32x4 kb[4], vb[4];
        { const AU a0 = au_decode(8 * gsel, part, Tseq); att_tiles_load(QKV, a0, head, 2 * a0.up - 1, tid, kb, vb); }
        int pgi = -1, prun = -1, pup = -9;
#pragma unroll 1
        for (int kk = 0; kk < 8; ++kk) { int gs_ = gsel; asm volatile("" : "+s"(gs_)); const int k = 8 * gs_ + kk;
            const AU a = au_decode(k, part, Tseq);
            if (a.gi != gi_cur) { gi_cur = a.gi; const float* bt = biastab + (a.gi * 16 + head) * 129;
#pragma unroll
                for (int ks = 0; ks < 6; ++ks)
#pragma unroll
                    for (int tau = 0; tau < 2; ++tau)
#pragma unroll
                        for (int e2 = 0; e2 < 2; ++e2) { int o0 = 32 * ks + 8 * g + 4 * tau + 2 * e2 - qi, o1 = o0 + 1; o0 = o0 < 0 ? 0 : (o0 > 128 ? 128 : o0); o1 = o1 < 0 ? 0 : (o1 > 128 ? 128 : o1);
                            biasp[ks][tau][e2] = cvt_pk_bf16(bt[o0] * LOG2E, bt[o1] * LOG2E); } }
            const bool cont = (a.gi == pgi) && (a.run == prun) && (a.up == pup + 1);
            pgi = a.gi; prun = a.run; pup = a.up;
            const int n = 2 * a.up + blk;
            const size_t tq = a.seqbase + (size_t)(64 * n + qi) * a.dil + a.cls; const int qcol = a.gi * 6144 + head * 128;
            bf16x8 qf[4];
#pragma unroll
            for (int s = 0; s < 4; ++s) qf[s] = *(const bf16x8*)(QKV + tq * NQKV + qcol + 32 * s + 8 * g);
            __syncthreads();
            if (!cont) { att_tiles_store(ring, 2 * a.up - 1, tid, kb, vb); att_tiles_load(QKV, a, head, 2 * a.up + 1, tid, kb, vb); }
            att_tiles_store(ring, 2 * a.up + 1, tid, kb, vb);
            __syncthreads();
            f32x4 sc[6][2];
#pragma unroll
            for (int ks = 0; ks < 6; ++ks) {
                const unsigned rbase = (unsigned)(((n - 1 + (ks >> 1)) & 3) * 64 + 32 * (ks & 1));
#pragma unroll
                for (int tau = 0; tau < 2; ++tau) {
                    const unsigned row = rbase + 8 * (l15 >> 2) + 4 * tau + (l15 & 3);
                    f32x4 acc = (f32x4){0.f, 0.f, 0.f, 0.f};
#pragma unroll
                    for (int s = 0; s < 4; ++s) { const bf16x8 kf = *(const LAS bf16x8*)(ring + v_off(row, 4 * s + g)); acc = __builtin_amdgcn_mfma_f32_16x16x32_bf16(kf, qf[s], acc, 0, 0, 0); }
                    sc[ks][tau] = acc;
                }
                if (ks & 1) __builtin_amdgcn_sched_barrier(0);
            }
            const bool first = (n == 0), last = (n == a.NT - 1);
            float mx = -1e30f;
#pragma unroll
            for (int ks = 0; ks < 6; ++ks)
#pragma unroll
                for (int tau = 0; tau < 2; ++tau)
#pragma unroll
                    for (int e = 0; e < 4; ++e) { const int j = 32 * ks + 8 * g + 4 * tau + e;
                        const bool ok = ks < 2 ? (j >= qi && !first) : (ks >= 4 ? (j - 128 <= qi && !last) : true);
                        const unsigned bw = biasp[ks][tau][e >> 1]; const float bv = (e & 1) ? bfhi(bw) : bflo(bw);
                        const float lg = ok ? sc[ks][tau][e] * SCALE + bv : -1e30f; sc[ks][tau][e] = lg; mx = fmaxf(mx, lg); }
            mx = rows_max(mx);
            float sum = 0.f; bf16x8 pf[6];
#pragma unroll
            for (int ks = 0; ks < 6; ++ks) { float p[8];
#pragma unroll
                for (int tau = 0; tau < 2; ++tau)
#pragma unroll
                    for (int e = 0; e < 4; ++e) { const float pe = __builtin_amdgcn_exp2f(sc[ks][tau][e] - mx); p[4 * tau + e] = pe; sum += pe; }
                u32x4 w; w.x = cvt_pk_bf16(p[0], p[1]); w.y = cvt_pk_bf16(p[2], p[3]); w.z = cvt_pk_bf16(p[4], p[5]); w.w = cvt_pk_bf16(p[6], p[7]); pf[ks] = __builtin_bit_cast(bf16x8, w); }
            sum = rows_sum(sum);
            const float inv = __builtin_amdgcn_rcpf(sum);
            if (kk + 1 < 8) { const AU nx = au_decode(k + 1, part, Tseq); const bool ncont = (nx.gi == a.gi) && (nx.run == a.run) && (nx.up == a.up + 1);
                att_tiles_load(QKV, nx, head, ncont ? 2 * nx.up + 1 : 2 * nx.up - 1, tid, kb, vb); }
            const unsigned q4 = (unsigned)l15 >> 2, pp = (unsigned)lane & 3u;
            const unsigned s0 = (unsigned)((n - 1) & 3) * 16384u, s1 = (unsigned)(n & 3) * 16384u, s2 = (unsigned)((n + 1) & 3) * 16384u;
            bf16* orow = OG + (size_t)a.gi * SLOT_ELEMS + tq * D + head * 128 + 4 * g;
#pragma unroll
            for (int c = 0; c < 8; ++c) {
                const unsigned r0 = 8u * g + q4, ch = 2u * c + (pp >> 1);
                const unsigned alo = vbase + v_off(r0, ch) + 8u * (pp & 1u), ahi = vbase + v_off(r0 + 4u, ch) + 8u * (pp & 1u);
                s16x4 l0[2], h0[2], l1[2], h1[2], l2[2], h2[2];
                tr_read4_nw(alo + s0, ahi + s0, l0, h0); tr_read4_nw(alo + s1, ahi + s1, l1, h1); tr_read4_nw(alo + s2, ahi + s2, l2, h2);
                tr_wait12(l0, h0, l1, h1, l2, h2);
                f32x4 oa = (f32x4){0.f, 0.f, 0.f, 0.f};
#define ATT_PV(L_, H_, KS_) oa = __builtin_amdgcn_mfma_f32_16x16x32_bf16((bf16x8){L_[0], L_[1], L_[2], L_[3], H_[0], H_[1], H_[2], H_[3]}, pf[KS_], oa, 0, 0, 0)
                ATT_PV(l0[0], h0[0], 0); ATT_PV(l0[1], h0[1], 1); ATT_PV(l1[0], h1[0], 2); ATT_PV(l1[1], h1[1], 3); ATT_PV(l2[0], h2[0], 4); ATT_PV(l2[1], h2[1], 5);
#undef ATT_PV
                u32x2 w; w.x = cvt_pk_bf16(oa[0] * inv, oa[1] * inv); w.y = cvt_pk_bf16(oa[2] * inv, oa[3] * inv);
                *(u32x2*)(orow + 16 * c) = w; }
            if (g == 0) LSE[(size_t)a.gi * S * 16 + tq * 16 + head] = (mx + __builtin_amdgcn_logf(sum)) * 0.6931471805599453f;
        }
    }
}
DI void phase_attn_combine(const Frame& F, const bf16* OG, const float* LSE, unsigned char* out, float* asc) {
    for (int row = F.gw; row < S; row += F.NGW) {
        float o[4][8]; float mx = 0.f;
#pragma unroll
        for (int jj = 0; jj < 4; ++jj) {
            const int c0 = 512 * jj + 8 * F.lane, head = c0 >> 7; const size_t e0 = (size_t)row * D + c0;
            const float l0 = LSE[(size_t)row * 16 + head], l1 = LSE[(size_t)S * 16 + (size_t)row * 16 + head], l2 = LSE[(size_t)2 * S * 16 + (size_t)row * 16 + head];
            const float m = fmaxf(l0, fmaxf(l1, l2)); float w0 = __expf(l0 - m), w1 = __expf(l1 - m), w2 = __expf(l2 - m); const float inv = 1.f / (w0 + w1 + w2); w0 *= inv; w1 *= inv; w2 *= inv;
            float a[8], b[8], c[8];
            unpack8(*(const u32x4*)(OG + e0), a); unpack8(*(const u32x4*)(OG + SLOT_ELEMS + e0), b); unpack8(*(const u32x4*)(OG + 2 * SLOT_ELEMS + e0), c);
#pragma unroll
            for (int e = 0; e < 8; ++e) { o[jj][e] = w0 * a[e] + w1 * b[e] + w2 * c[e]; mx = fmaxf(mx, fabsf(o[jj][e])); }
        }
        mx = wave_max(mx); const float qi = mx > 0.f ? 127.f / mx : 0.f;
#pragma unroll
        for (int jj = 0; jj < 4; ++jj) { u32x2 w; w.x = pack4_i8(o[jj][0] * qi, o[jj][1] * qi, o[jj][2] * qi, o[jj][3] * qi); w.y = pack4_i8(o[jj][4] * qi, o[jj][5] * qi, o[jj][6] * qi, o[jj][7] * qi);
            *(u32x2*)(out + (size_t)row * D + 512 * jj + 8 * F.lane) = w; }
        if (F.lane == 0) asc[row] = mx * (1.f / 127.f);
    }
}
constexpr int QPL = 16;
#ifndef PG_ALIGN
#define PG_ALIGN true
#endif
#ifndef PG_SP2
#define PG_SP2 true
#endif
__global__ void __launch_bounds__(NWAVES * 64, 2) fwd_kernel(Args a_unused) {
    extern __shared__ __attribute__((aligned(16))) unsigned char lds[];
#define MKFRAME() Frame F; { int tid_; asm volatile("v_mbcnt_lo_u32_b32 %0, -1, 0\n\tv_mbcnt_hi_u32_b32 %0, -1, %0" : "=v"(tid_)); tid_ += wave_s * 64;     int bx_ = blockIdx.x, g_ = gridDim.x; asm volatile("" : "+s"(bx_), "+s"(g_)); \
        F.lds = (LAS unsigned char*)lds; F.ldsg = lds; F.tid = tid_; F.lane = tid_ & 63; F.wave = __builtin_amdgcn_readfirstlane(tid_ >> 6); \
        F.G = g_; F.vcu = (g_ % 8 == 0) ? (bx_ % 8) * (g_ / 8) + bx_ / 8 : bx_; F.gw = F.vcu * NWAVES + F.wave; F.NGW = g_ * NWAVES; }
    const int wave_s = __builtin_amdgcn_readfirstlane((int)threadIdx.x >> 6);
    volatile LAS unsigned* MISC = (volatile LAS unsigned*)((LAS unsigned char*)lds + MISC_OFF);
    for (int u = threadIdx.x; u < (LDS_BYTES - LDSCTL_OFF) / 4; u += NWAVES * 64) ((LAS unsigned*)((LAS unsigned char*)lds + LDSCTL_OFF))[u] = 0u;
    __syncthreads();
    int slab_lo, slab_hi, ph_lo, ph_hi, use_bar, do_pro;
    XcdBarrier bar;
    { ArgsP ap = args_ptr(); slab_lo = ap->slab_lo; slab_hi = ap->slab_hi; ph_lo = ap->ph_lo; ph_hi = ap->ph_hi; use_bar = ap->use_bar; do_pro = ap->do_pro;
      bar.bar = (unsigned*)(ap->ws + WS_CTL) + CW_BAR; bar.x = 0; bar.st = nullptr; bar.w = wave_s;
      if (use_bar) { bar = xcd_barrier_post((unsigned*)(ap->ws + WS_CTL) + CW_BAR, MISC + 8); bar.w = wave_s; } }
#define SEAM() do { if (use_bar) xcd_barrier(bar); } while (0)
#define SLOT(i) ((bf16*)(ws + WS_SLOT) + (size_t)(i) * SLOT_ELEMS)
#define LDA() MKFRAME(); ArgsP ap = args_ptr(); unsigned char* ws = ap->ws; (void)ws; const int c_ord = (int)blockIdx.x; (void)c_ord

    if (do_pro & 1) { MKFRAME(); p0_scales(F); SEAM(); }
    if (do_pro & 2) { MKFRAME(); p0_prologue(F); SEAM(); }

    for (int slab = slab_lo; slab < slab_hi; ++slab) {
        const int nseq = slab < 2 ? 8 : 1, Tseq = S / nseq;
#pragma unroll 1
        for (int layer = 0; layer < 2; ++layer) {
            const int step0 = (slab * 2 + layer) * QPL;
#if MK_ONE_LAUNCH
#define RUN(q) true
#else
#define RUN(q) (ph_lo <= step0 + (q) && step0 + (q) < ph_hi)
#endif
#define XIN ((slab < 2 ? ap->in[0] : ap->in[1]) + (size_t)(slab & 1) * S * D)
#define XOUT (ap->out + (size_t)slab * S * D)
#define XBF ((bf16*)XOUT + (size_t)S * D)
#define GAINS (ap->in[4] + (size_t)layer * 4 * D)
#define PIN ((slab < 2 ? ap->in[2] : ap->in[3]) + ((size_t)layer * 2 * S + (size_t)(slab & 1) * S) * PLE)
            if (layer == 0) {
                if (RUN(0)) { LDA(); phase_mix(F, XIN, Tseq, GAINS, ap->in[6], SLOT(0)); SEAM(); }
                if (RUN(1)) { LDA();
                    pg8::Gemm g{SLOT(0), (const bf16*)(ws + WS_WB0), D}; pg8::MultiOrder<pg8::TabL0B> O{F.G, c_ord};
                    pg8::EpiL0B E{SLOT(6), (bf16*)(ws + WS_HL)};
                    pg8::gemm_phase<pg8::EpiL0B, pg8::MultiOrder<pg8::TabL0B>, PG_ALIGN, PG_SP2>(F.lds, g, O, E, F.tid); SEAM(); }
                if (RUN(2)) { LDA();
                    pg8::Gemm g{(const bf16*)(ws + WS_HL), (const bf16*)(ws + WS_WL2), 256}; pg8::MultiOrder<pg8::TabL0C> O{F.G, c_ord};
                    pg8::EpiL0C E{SLOT(0), ap->in[8], ap->in[11]};
                    pg8::gemm_phase<pg8::EpiL0C, pg8::MultiOrder<pg8::TabL0C>, PG_ALIGN, PG_SP2>(F.lds, g, O, E, F.tid); SEAM(); }
                if (RUN(3) && nseq == 1) { LDA(); phase_wkv<1>(F, nseq, SLOT(6), SLOT(7), SLOT(8), SLOT(0), ap->in[16], ap->in[17], ap->in[18], SLOT(9), (float*)(ws + WS_PT), SLOT(11), (float*)(ws + WS_PB)); SEAM(); }
                if (RUN(4)) { LDA(); if (nseq == 1) phase_wkv_fix(F, (const float*)(ws + WS_PT), SLOT(11), SLOT(9)); else phase_wkv<0>(F, nseq, SLOT(6), SLOT(7), SLOT(8), SLOT(0), ap->in[16], ap->in[17], ap->in[18], SLOT(9), (float*)(ws + WS_PT), nullptr, (float*)(ws + WS_PB)); SEAM(); }
                if (RUN(5)) { LDA(); phase_post(F, SLOT(9), SLOT(10), SLOT(8), SLOT(4), (const float*)(ws + WS_PB), ap->in[19], ap->in[20], SLOT(5)); SEAM(); }
            } else {
                if (RUN(0)) { LDA(); phase_resnorm<false, false>(F, XBF, nullptr, nullptr, nullptr, GAINS, (unsigned char*)SLOT(0), (float*)(ws + WS_ASC), nullptr, nullptr); SEAM(); }
#pragma unroll 1
                for (int gi = 0; gi < 3; ++gi) {
                    if (RUN(1 + 2 * gi)) { LDA();
                        pg8::Gemm g{SLOT(0), (const bf16*)(ws + WS_WQKV) + (size_t)gi * 6144 * (D / 2), D / 2}; pg8::MultiOrder<pg8::TabOne<24>> O{F.G, c_ord};
                        pg8::EpiPlainI8 E{SLOT(1) + gi * 6144, NQKV, (const float*)(ws + WS_ASC), (const float*)(ws + WS_WSC) + WSC_QKV + gi * 6144};
                        pg8::gemm_phase<pg8::EpiPlainI8, pg8::MultiOrder<pg8::TabOne<24>>, PG_ALIGN, PG_SP2>(F.lds, g, O, E, F.tid); SEAM(); }
                    if (RUN(2 + 2 * gi)) { LDA(); phase_attn(F, SLOT(1), Tseq, (const float*)(ws + WS_BIAS), SLOT(10), (float*)(ws + WS_LSE), gi); SEAM(); }
                }
                if (RUN(7)) { LDA(); phase_attn_combine(F, SLOT(10), (const float*)(ws + WS_LSE), (unsigned char*)SLOT(0), (float*)(ws + WS_ASC)); SEAM(); }
                if (RUN(8)) { LDA();
                    pg8::Gemm g{SLOT(0), (const bf16*)(ws + WS_WO1), D / 2}; pg8::MultiOrder<pg8::TabOne<8>> O{F.G, c_ord};
                    pg8::EpiPlainI8 E{SLOT(1), D, (const float*)(ws + WS_ASC), (const float*)(ws + WS_WSC) + WSC_WO + D};
                    pg8::gemm_phase<pg8::EpiPlainI8, pg8::MultiOrder<pg8::TabOne<8>>, PG_ALIGN, PG_SP2>(F.lds, g, O, E, F.tid); SEAM(); }
            }
            const int sA = layer ? 0 : 5, sB = layer ? 1 : 0, sC = layer ? 2 : 1, sD = layer ? 3 : 2, sE = layer ? 6 : 5;
            if (RUN(9) && layer == 0) { LDA();
                pg8::Gemm g{SLOT(sA), (const bf16*)(ws + WS_WO0), D}; pg8::MultiOrder<pg8::TabOne<8>> O{F.G, c_ord};
                pg8::EpiPlain E{SLOT(sB), D};
                pg8::gemm_phase<pg8::EpiPlain, pg8::MultiOrder<pg8::TabOne<8>>, PG_ALIGN, PG_SP2>(F.lds, g, O, E, F.tid); SEAM(); }
            if (RUN(10)) { LDA(); if (layer == 0) phase_resnorm<true, true>(F, XIN, XBF, SLOT(sB), GAINS + D, GAINS + 2 * D, (unsigned char*)SLOT(sC), (float*)(ws + WS_ASC), PIN, (bf16*)(ws + WS_PB));
                else phase_resnorm<true, false>(F, XBF, XBF, SLOT(sB), GAINS + D, GAINS + 2 * D, (unsigned char*)SLOT(sC), (float*)(ws + WS_ASC), PIN, (bf16*)(ws + WS_PB)); SEAM(); }
            if (RUN(11)) { LDA();
                pg8::Gemm g{SLOT(sC), (const bf16*)(ws + WS_WGU) + (size_t)layer * FF * D, D / 2}; pg8::MultiOrder<pg8::TabOne<44>> O{F.G, c_ord};
                pg8::EpiSwiGLUI8 E{SLOT(sD), (const float*)(ws + WS_ASC), (const float*)(ws + WS_WSC) + WSC_GU + layer * 2 * FF};
                pg8::gemm_phase<pg8::EpiSwiGLUI8, pg8::MultiOrder<pg8::TabOne<44>>, PG_ALIGN, PG_SP2>(F.lds, g, O, E, F.tid); SEAM(); }
            if (RUN(14)) { LDA(); phase_quant_hidden(F, SLOT(sD), (unsigned char*)SLOT(10), (float*)(ws + WS_ASC)); SEAM(); }
            if (RUN(12)) { LDA();
                { pg8::Gemm g{SLOT(10), (const bf16*)(ws + WS_WDN) + (size_t)layer * D * FF, FF / 2}; pg8::MultiOrder<pg8::TabOne<8>> O{F.G, c_ord};
                  pg8::EpiPlainI8 E{SLOT(sB), D, (const float*)(ws + WS_ASC), (const float*)(ws + WS_WSC) + WSC_DN + (layer ? 0 : 2048)};
                  pg8::gemm_phase<pg8::EpiPlainI8, pg8::MultiOrder<pg8::TabOne<8>>, PG_ALIGN, PG_SP2>(F.lds, g, O, E, F.tid); }
                { pg8::Gemm g{(const bf16*)(ws + WS_PB), (const bf16*)(ws + WS_WPP) + (size_t)layer * D * PLE, PLE}; pg8::MultiOrder<pg8::TabOne<8>> O{F.G, c_ord};
                  pg8::EpiPlain E{SLOT(sE), D};
                  pg8::gemm_phase<pg8::EpiPlain, pg8::MultiOrder<pg8::TabOne<8>>, PG_ALIGN, PG_SP2>(F.lds, g, O, E, F.tid); }
                SEAM(); }
            if (RUN(13)) { LDA(); phase_resnorm<true, false>(F, XBF, layer ? SLOT(7) : XBF, SLOT(sB), GAINS + 3 * D, ap->in[26] + (size_t)layer * D, (unsigned char*)SLOT(sC), (float*)(ws + WS_ASC), nullptr, nullptr); SEAM(); }
            if (RUN(15)) { LDA();
                pg8::Gemm g{SLOT(sC), (const bf16*)(ws + WS_WPG) + (size_t)layer * D * D / 2, D / 2}; pg8::MultiOrder<pg8::TabOne<8>> O{F.G, c_ord};
                pg8::EpiPleGateI8 E{layer ? SLOT(7) : XBF, XBF, layer ? XOUT : nullptr, SLOT(sE), (const float*)(ws + WS_ASC), (const float*)(ws + WS_WSC) + WSC_PG + layer * D};
                pg8::gemm_phase<pg8::EpiPleGateI8, pg8::MultiOrder<pg8::TabOne<8>>, PG_ALIGN, PG_SP2>(F.lds, g, O, E, F.tid); SEAM(); }
#undef RUN
        }
    }
}

extern "C" void kernel_launch(void* const* d_in, const int* in_sizes, int n_in, void* d_out, int out_size, void* d_ws, size_t ws_size, hipStream_t stream) {
    static int grid = 0;
    if (grid == 0) {
        if (n_in != 29 || ws_size < WS_END) { fprintf(stderr, "kernel_launch: unexpected inputs (n_in %d, ws %zu)\n", n_in, ws_size); grid = -1; return; }
        int dev = 0, cus = 0, per_cu = 0;
        if (hipGetDevice(&dev) != hipSuccess || hipDeviceGetAttribute(&cus, hipDeviceAttributeMultiprocessorCount, dev) != hipSuccess) { grid = -1; return; }
        if (hipFuncSetAttribute((const void*)fwd_kernel, hipFuncAttributeMaxDynamicSharedMemorySize, LDS_BYTES) != hipSuccess) { fprintf(stderr, "kernel_launch: hipFuncSetAttribute failed\n"); grid = -1; return; }
        if (hipOccupancyMaxActiveBlocksPerMultiprocessor(&per_cu, (const void*)fwd_kernel, NWAVES * 64, LDS_BYTES) != hipSuccess || per_cu < 1) fprintf(stderr, "kernel_launch: occupancy query says %d\n", per_cu);
        (void)hipGetLastError();
        grid = cus;
    }
    if (grid < 0) return;
    (void)hipMemsetAsync((char*)d_ws + WS_CTL, 0, CTL_BYTES, stream);
    Args a{};
    for (int i = 0; i < 29; ++i) a.in[i] = (const float*)d_in[i];
    a.out = (float*)d_out; a.ws = (unsigned char*)d_ws;
#if MK_ONE_LAUNCH
    a.slab_lo = 0; a.slab_hi = NSLAB; a.ph_lo = 0; a.ph_hi = NSLAB * 2 * QPL; a.use_bar = 1; a.do_pro = 3;
    hipLaunchKernelGGL(fwd_kernel, dim3(grid), dim3(NWAVES * 64), LDS_BYTES, stream, a);
#else
    a.use_bar = 0;
    a.slab_lo = 0; a.slab_hi = 0; a.ph_lo = 0; a.ph_hi = 0; a.do_pro = 1;
    hipLaunchKernelGGL(fwd_kernel, dim3(grid), dim3(NWAVES * 64), LDS_BYTES, stream, a);
    a.do_pro = 2;
    hipLaunchKernelGGL(fwd_kernel, dim3(grid), dim3(NWAVES * 64), LDS_BYTES, stream, a);
    a.do_pro = 0;
    for (int slab = 0; slab < NSLAB; ++slab)
        for (int layer = 0; layer < 2; ++layer)
            for (int q = 0; q < QPL; ++q) {
                if ((layer == 0 ? ((q == 3 && slab < 2) || (q >= 6 && q <= 8)) : (q == 9)) || q == 14) continue;
                a.slab_lo = slab; a.slab_hi = slab + 1; a.ph_lo = (slab * 2 + layer) * QPL + q; a.ph_hi = a.ph_lo + 1;
                hipLaunchKernelGGL(fwd_kernel, dim3(grid), dim3(NWAVES * 64), LDS_BYTES, stream, a);
            }
#endif
}
```

```cpp
#include <hip/hip_runtime.h>
#include <cstdio>
#include <cstdint>

#define GAS __attribute__((address_space(1)))
#define LAS __attribute__((address_space(3)))
#define DI __device__ __forceinline__
typedef unsigned short bf16;
typedef short bf16x8 __attribute__((ext_vector_type(8)));
typedef short s16x4 __attribute__((ext_vector_type(4)));
typedef float f32x4 __attribute__((ext_vector_type(4)));
typedef float f32x2 __attribute__((ext_vector_type(2)));
typedef unsigned u32x4 __attribute__((ext_vector_type(4)));
typedef unsigned u32x2 __attribute__((ext_vector_type(2)));

constexpr int D = 2048, FF = 5632, NQKV = 18432, PLE = 256;
constexpr int S = 16384;
constexpr int NSLAB = 4;
constexpr int NPANEL = S / 256;
constexpr float NORM_EPS = 1e-6f, GN_EPS = 64e-5f;

constexpr size_t MiB = 1u << 20;
constexpr size_t WS_CTL = 0, CTL_BYTES = 1 * MiB;
constexpr size_t WS_BIAS = 1 * MiB;
constexpr size_t WS_WSC = 1 * MiB + 64 * 1024;
constexpr int WSC_QKV = 0, WSC_GU = 18432, WSC_PG = 18432 + 2 * 11264, WSC_WO = WSC_PG + 2 * 2048, WSC_DN = WSC_WO + 2 * 2048  ;
constexpr size_t WS_WB0 = 2 * MiB;
constexpr size_t WS_WL2 = 29 * MiB;
constexpr size_t WS_WO0 = 34 * MiB;
constexpr size_t WS_WQKV = 42 * MiB;
constexpr size_t WS_WO1 = 114 * MiB;
constexpr size_t WS_WGU = 122 * MiB;
constexpr size_t WS_WDN = 210 * MiB;
constexpr size_t WS_WPG = 254 * MiB;
constexpr size_t WS_WPP = 270 * MiB;
constexpr size_t WS_HL = 272 * MiB;
constexpr size_t WS_PB = 296 * MiB;
constexpr size_t WS_LSE = 304 * MiB;
constexpr size_t WS_ASC = 307 * MiB;
constexpr size_t WS_SLOT = 308 * MiB;
constexpr size_t SLOT_BYTES = 64 * MiB;
constexpr size_t WS_PT = WS_SLOT + 13 * SLOT_BYTES;
constexpr size_t WS_END = WS_PT + 16 * MiB;
constexpr size_t SLOT_ELEMS = (size_t)S * D;

DI float bf2f(unsigned short b) { return __uint_as_float(((unsigned)b) << 16); }
DI float bflo(unsigned w) { return __uint_as_float(w << 16); }
DI float bfhi(unsigned w) { return __uint_as_float(w & 0xffff0000u); }
typedef __bf16 bf16v2_t __attribute__((ext_vector_type(2)));
DI unsigned cvt_pk_bf16(float lo, float hi) { bf16v2_t v; v.x = (__bf16)lo; v.y = (__bf16)hi; return __builtin_bit_cast(unsigned, v); }
DI unsigned short f2bf(float f) { return (unsigned short)(cvt_pk_bf16(f, 0.f) & 0xffffu); }
template <int CTRL> DI float dpp_mov(float v) { return __int_as_float(__builtin_amdgcn_update_dpp(0, __float_as_int(v), CTRL, 0xf, 0xf, true)); }
#define DPP_XOR1 0xB1
#define DPP_XOR2 0x4E
#define DPP_HMIRROR 0x141
#define DPP_MIRROR 0x140
DI float row16_sum(float v) { v += dpp_mov<DPP_XOR1>(v); v += dpp_mov<DPP_XOR2>(v); v += dpp_mov<DPP_HMIRROR>(v); v += dpp_mov<DPP_MIRROR>(v); return v; }
DI float oct_sum(float v) { v += dpp_mov<DPP_XOR1>(v); v += dpp_mov<DPP_XOR2>(v); v += dpp_mov<DPP_HMIRROR>(v); return v; }
DI float wave_sum(float v) {
    v = row16_sum(v);
    const int iv = __float_as_int(v);
    return (__int_as_float(__builtin_amdgcn_readlane(iv, 0)) + __int_as_float(__builtin_amdgcn_readlane(iv, 16))) + (__int_as_float(__builtin_amdgcn_readlane(iv, 32)) + __int_as_float(__builtin_amdgcn_readlane(iv, 48)));
}
DI float rows_sum(float v) { auto a = __builtin_amdgcn_permlane16_swap(__float_as_uint(v), __float_as_uint(v), false, false); v = __uint_as_float(a[0]) + __uint_as_float(a[1]);
    auto b = __builtin_amdgcn_permlane32_swap(__float_as_uint(v), __float_as_uint(v), false, false); return __uint_as_float(b[0]) + __uint_as_float(b[1]); }
DI float rows_max(float v) { auto a = __builtin_amdgcn_permlane16_swap(__float_as_uint(v), __float_as_uint(v), false, false); v = fmaxf(__uint_as_float(a[0]), __uint_as_float(a[1]));
    auto b = __builtin_amdgcn_permlane32_swap(__float_as_uint(v), __float_as_uint(v), false, false); return fmaxf(__uint_as_float(b[0]), __uint_as_float(b[1])); }
#define DPP_QREV 0x1B
DI float wave_sum8(const float (&v)[8], int lane) {
    const bool b0 = lane & 1, b1 = lane & 2, b2 = lane & 4;
    float t[4], u[2];
#pragma unroll
    for (int i = 0; i < 4; ++i) { const float keep = b0 ? v[i + 4] : v[i], send = b0 ? v[i] : v[i + 4]; t[i] = keep + dpp_mov<DPP_XOR1>(send); }
#pragma unroll
    for (int i = 0; i < 2; ++i) { const float keep = b1 ? t[i + 2] : t[i], send = b1 ? t[i] : t[i + 2]; u[i] = keep + dpp_mov<DPP_XOR2>(send); }
    const float keep = b2 ? u[1] : u[0], send = b2 ? u[0] : u[1];
    float w = keep + dpp_mov<DPP_QREV>(dpp_mov<DPP_HMIRROR>(send));
    w += dpp_mov<DPP_MIRROR>(dpp_mov<DPP_HMIRROR>(w));
    return rows_sum(w);
}
constexpr int bitrev3(int e) { return ((e & 1) << 2) | (e & 2) | ((e >> 2) & 1); }
DI float wave_max(float v) {
    v = fmaxf(v, dpp_mov<DPP_XOR1>(v)); v = fmaxf(v, dpp_mov<DPP_XOR2>(v)); v = fmaxf(v, dpp_mov<DPP_HMIRROR>(v)); v = fmaxf(v, dpp_mov<DPP_MIRROR>(v));
    const int iv = __float_as_int(v);
    return fmaxf(fmaxf(__int_as_float(__builtin_amdgcn_readlane(iv, 0)), __int_as_float(__builtin_amdgcn_readlane(iv, 16))), fmaxf(__int_as_float(__builtin_amdgcn_readlane(iv, 32)), __int_as_float(__builtin_amdgcn_readlane(iv, 48))));
}
DI unsigned q8(float v) { return (unsigned)__float2int_rn(v) & 0xffu; }
DI unsigned pack4_i8(float a, float b, float c, float d) { return q8(a) | (q8(b) << 8) | (q8(c) << 16) | (q8(d) << 24); }
DI float rsqrt_fast(float x) { return __builtin_amdgcn_rsqf(x); }
DI float sigmoidf_(float x) { return 1.f / (1.f + __expf(-x)); }
#define LDS_WAIT() asm volatile("s_waitcnt lgkmcnt(0)" ::: "memory")
#define VM_WAIT() asm volatile("s_waitcnt vmcnt(0)" ::: "memory")
#ifndef MK_ONE_LAUNCH
#define MK_ONE_LAUNCH 1
#endif
namespace pg8 {
#define PG8_LAS __attribute__((address_space(3)))
typedef unsigned short bf16_t;
constexpr int BM = 256, BK = 64, HALF = 128, HTB = HALF * BK * 2  , STAGE_BYTES = 8 * HTB, NXCD = 8, WGM = 8;

__host__ __device__ __forceinline__ int lds_byte(int r, int c) { const int st = (r >> 4) * 2 + (c >> 5), rr = r & 15, cc = c & 31, ob = rr * 64 + cc * 2; return st * 1024 + (ob ^ (((ob >> 9) & 1) << 5)); }
__host__ __device__ __forceinline__ void stage_rc(int b, int& R, int& C) { const int st = b / 1024, sb = b % 1024, swz = sb ^ (((sb >> 9) & 1) << 5); R = (st >> 1) * 16 + swz / 64; C = (st & 1) * 32 + (swz % 64) / 2; }
__host__ __device__ __forceinline__ int perm32(int rho) { const int n = rho >> 4, i = rho & 15; return 8 * (i >> 2) + 4 * n + (i & 3); }

typedef int i32x4 __attribute__((ext_vector_type(4)));
template <class ACC> __device__ __forceinline__ ACC mma_sel(const bf16x8& a, const bf16x8& b, const ACC& c);
template <> __device__ __forceinline__ f32x4 mma_sel<f32x4>(const bf16x8& a, const bf16x8& b, const f32x4& c) { return __builtin_amdgcn_mfma_f32_16x16x32_bf16(a, b, c, 0, 0, 0); }
template <> __device__ __forceinline__ i32x4 mma_sel<i32x4>(const bf16x8& a, const bf16x8& b, const i32x4& c) { return __builtin_amdgcn_mfma_i32_16x16x64_i8(__builtin_bit_cast(i32x4, a), __builtin_bit_cast(i32x4, b), c, 0, 0, 0); }
struct Unit { int pm, pn, aux; };
struct Gemm { const bf16_t* A; const bf16_t* Bt; int K; };

template <class Tab> struct MultiOrder {
    int G, c;
    __device__ __forceinline__ bool next(int i, Unit& u) const {
        int L = i * G + c;
#pragma unroll
        for (int j = 0; j < Tab::NP; ++j) {
            const int nM = Tab::nM(j), nN = Tab::nN(j), nwg = nM * nN;
            if (L < nwg) {
                int wgid = L; { const int q = nwg / NXCD, r = nwg % NXCD, xcd = wgid % NXCD, off = wgid / NXCD; wgid = (xcd < r ? xcd * (q + 1) : r * (q + 1) + (xcd - r) * q) + off; }
                const int nig = WGM * nN, gid = wgid / nig, fm = gid * WGM, gsz = (nM - fm) < WGM ? (nM - fm) : WGM;
                u.pm = Tab::pm0(j) + fm + ((wgid % nig) % gsz); u.pn = Tab::pn0(j) + (wgid % nig) / gsz; u.aux = j; return true;
            }
            L -= nwg;
        }
        return false;
    }
    __device__ __forceinline__ void a_ready(const Unit&) const {}
    __device__ __forceinline__ void done(const Unit&) const {}
};
template <class Epi, class Sched, bool ALIGN_EPI = false, bool SP2 = false>
__device__ __forceinline__ void gemm_phase(PG8_LAS unsigned char* lds, const Gemm g, const Sched& S, const Epi& E, const int tid) {
    const int wid = __builtin_amdgcn_readfirstlane(tid >> 6), lane = tid & 63, wr = wid >> 2, wc = wid & 3, fr = lane & 15, fq = lane >> 4;
    const int K = g.K, nt = K / BK;
    unsigned voffA[2], voffB[2];
#pragma unroll
    for (int i = 0; i < 2; ++i) { int R, C; stage_rc(tid * 16 + i * 8192, R, C); const int Rb = Epi::PERM ? ((R & ~31) + perm32(R & 31)) : R;
        voffA[i] = (unsigned)(R * K + C) * 2u; voffB[i] = (unsigned)(Rb * K + C) * 2u; }
    const size_t kstep = (size_t)(BK * 2);
    const size_t hstep = (size_t)HALF * K * 2;
    const size_t tstep = 2 * hstep;
    const unsigned ldsw = (unsigned)wid * 1024u;
    const int aoff = lds_byte(wr * 64 + fr, fq * 8), boff = lds_byte(wc * 32 + fr, fq * 8);
#define PG8_SA(b, h) (((b) * 2 + (h)) * HTB)
#define PG8_SB(b, h) ((4 + (b) * 2 + (h)) * HTB)
#define PG8_STAGE(bufoff, gbase, voff) do { _Pragma("unroll") for (int _i = 0; _i < 2; ++_i) \
        __builtin_amdgcn_global_load_lds((const unsigned*)((const char*)(gbase) + (voff)[_i]), (PG8_LAS unsigned*)(lds + (bufoff) + ldsw + _i * 8192), 16, 0, 0); } while (0)
#define PG8_LDA(dst, b, h) do { _Pragma("unroll") for (int m = 0; m < 4; ++m) _Pragma("unroll") for (int k = 0; k < 2; ++k) dst[m][k] = *(const PG8_LAS bf16x8*)(lds + PG8_SA(b, h) + aoff + m * 2048 + k * 1024); } while (0)
#define PG8_LDB(dst, b, h) do { _Pragma("unroll") for (int n = 0; n < 2; ++n) _Pragma("unroll") for (int k = 0; k < 2; ++k) dst[n][k] = *(const PG8_LAS bf16x8*)(lds + PG8_SB(b, h) + boff + n * 2048 + k * 1024); } while (0)
#define PG8_MMA(ai, bj, At, Bt) do { __builtin_amdgcn_s_setprio(1); _Pragma("unroll") for (int m = 0; m < 4; ++m) _Pragma("unroll") for (int n = 0; n < 2; ++n) _Pragma("unroll") for (int k = 0; k < 2; ++k) \
        acc[ai][bj][m][n] = mma_sel<acc_t>(Bt[n][k], At[m][k], acc[ai][bj][m][n]); __builtin_amdgcn_s_setprio(0); } while (0)
#define PG8_WAIT_V(n) asm volatile("s_waitcnt vmcnt(" #n ")" ::: "memory")
#define PG8_WAIT_L(n) asm volatile("s_waitcnt lgkmcnt(" #n ")" ::: "memory")
#define PG8_BAR __builtin_amdgcn_s_barrier()
#define PG8_SCHED __builtin_amdgcn_sched_barrier(0)
    Unit cur, nxt; int ui = 0;
    if (!S.next(0, cur)) return;
    typedef typename Epi::acc_t acc_t; acc_t acc[2][2][4][2];
#pragma unroll
    for (int a = 0; a < 2; ++a)
#pragma unroll
        for (int b = 0; b < 2; ++b)
#pragma unroll
            for (int m = 0; m < 4; ++m)
#pragma unroll
                for (int n = 0; n < 2; ++n) acc[a][b][m][n] = acc_t{};
    bf16x8 At[4][2], B0[2][2], B1[2][2];
    const char* cA = (const char*)g.A + (size_t)cur.pm * tstep; const char* cB = (const char*)g.Bt + (size_t)cur.pn * tstep;
    S.a_ready(cur);
    if constexpr (SP2) {
        PG8_STAGE(PG8_SB(0, 0), cB, voffB); PG8_STAGE(PG8_SB(0, 1), cB + hstep, voffB); PG8_STAGE(PG8_SA(0, 0), cA, voffA); PG8_STAGE(PG8_SA(0, 1), cA + hstep, voffA);
        if (wr == 1) PG8_BAR;
        PG8_WAIT_V(2); PG8_BAR;
        PG8_STAGE(PG8_SB(1, 0), cB + kstep, voffB); PG8_STAGE(PG8_SA(1, 0), cA + kstep, voffA); PG8_STAGE(PG8_SB(1, 1), cB + hstep + kstep, voffB);
        PG8_WAIT_V(6); PG8_BAR;
    } else {
        PG8_STAGE(PG8_SB(0, 0), cB, voffB); PG8_STAGE(PG8_SA(0, 0), cA, voffA); PG8_STAGE(PG8_SB(0, 1), cB + hstep, voffB); PG8_STAGE(PG8_SA(0, 1), cA + hstep, voffA);
        if (wr == 1) PG8_BAR;
        PG8_WAIT_V(4); PG8_BAR;
        PG8_STAGE(PG8_SB(1, 0), cB + kstep, voffB); PG8_STAGE(PG8_SA(1, 0), cA + kstep, voffA); PG8_STAGE(PG8_SB(1, 1), cB + hstep + kstep, voffB);
        PG8_WAIT_V(6); PG8_BAR;
    }
    for (;;) {
        const bool has_next = S.next(ui + 1, nxt);
        const char* nA = has_next ? (const char*)g.A + (size_t)nxt.pm * tstep : cA; const char* nB = has_next ? (const char*)g.Bt + (size_t)nxt.pn * tstep : cB;
        for (int t = 0; t < nt; t += 2) {
            const bool last = (t == nt - 2);
            const char* a1 = cA + (size_t)(t + 1) * kstep;
            const char* a2 = last ? nA : cA + (size_t)(t + 2) * kstep; const char* b2 = last ? nB : cB + (size_t)(t + 2) * kstep;
            const char* a3 = a2 + kstep; const char* b3 = b2 + kstep;
            if (last && has_next) S.a_ready(nxt);
            if constexpr (SP2) {
            PG8_LDB(B0, 0, 0); PG8_LDB(B1, 0, 1); PG8_SCHED; PG8_LDA(At, 0, 0); PG8_STAGE(PG8_SA(1, 1), a1 + hstep, voffA);
            PG8_WAIT_V(8); PG8_WAIT_L(0); PG8_BAR; PG8_MMA(0, 0, At, B0); PG8_MMA(0, 1, At, B1); PG8_BAR; PG8_SCHED;
            PG8_LDA(At, 0, 1); PG8_STAGE(PG8_SB(0, 0), b2, voffB); PG8_STAGE(PG8_SB(0, 1), b2 + hstep, voffB); PG8_STAGE(PG8_SA(0, 0), a2, voffA);
            PG8_WAIT_V(8); PG8_WAIT_L(0); PG8_BAR; PG8_MMA(1, 0, At, B0); PG8_MMA(1, 1, At, B1); PG8_BAR; PG8_SCHED;
            PG8_LDB(B0, 1, 0); PG8_LDB(B1, 1, 1); PG8_SCHED; PG8_LDA(At, 1, 0); PG8_STAGE(PG8_SA(0, 1), a2 + hstep, voffA);
            PG8_WAIT_V(8); PG8_WAIT_L(0); PG8_BAR; PG8_MMA(0, 0, At, B0); PG8_MMA(0, 1, At, B1); PG8_BAR; PG8_SCHED;
            PG8_LDA(At, 1, 1); PG8_STAGE(PG8_SB(1, 0), b3, voffB); PG8_STAGE(PG8_SB(1, 1), b3 + hstep, voffB); PG8_STAGE(PG8_SA(1, 0), a3, voffA);
            PG8_WAIT_V(8); PG8_WAIT_L(0); PG8_BAR; PG8_MMA(1, 0, At, B0); PG8_MMA(1, 1, At, B1); PG8_BAR; PG8_SCHED;
            } else {
            PG8_LDB(B0, 0, 0); PG8_SCHED; PG8_LDA(At, 0, 0); PG8_STAGE(PG8_SA(1, 1), a1 + hstep, voffA);
            PG8_WAIT_L(8); PG8_BAR; PG8_WAIT_L(0); PG8_MMA(0, 0, At, B0); PG8_BAR; PG8_SCHED;
            PG8_LDB(B1, 0, 1); PG8_STAGE(PG8_SB(0, 0), b2, voffB);
            PG8_BAR; PG8_WAIT_L(0); PG8_MMA(0, 1, At, B1); PG8_BAR;
            PG8_LDA(At, 0, 1); PG8_STAGE(PG8_SA(0, 0), a2, voffA);
            PG8_BAR; PG8_WAIT_L(0); PG8_MMA(1, 0, At, B0); PG8_BAR; PG8_SCHED;
            PG8_STAGE(PG8_SB(0, 1), b2 + hstep, voffB);
            PG8_WAIT_V(6); PG8_BAR; PG8_MMA(1, 1, At, B1); PG8_BAR;
            PG8_LDB(B0, 1, 0); PG8_SCHED; PG8_LDA(At, 1, 0); PG8_STAGE(PG8_SA(0, 1), a2 + hstep, voffA);
            PG8_WAIT_L(8); PG8_BAR; PG8_WAIT_L(0); PG8_MMA(0, 0, At, B0); PG8_BAR; PG8_SCHED;
            PG8_LDB(B1, 1, 1); PG8_STAGE(PG8_SB(1, 0), b3, voffB);
            PG8_BAR; PG8_WAIT_L(0); PG8_MMA(0, 1, At, B1); PG8_BAR;
            PG8_LDA(At, 1, 1); PG8_STAGE(PG8_SA(1, 0), a3, voffA);
            PG8_BAR; PG8_WAIT_L(0); PG8_MMA(1, 0, At, B0); PG8_BAR; PG8_SCHED;
            PG8_STAGE(PG8_SB(1, 1), b3 + hstep, voffB);
            PG8_WAIT_V(6); PG8_BAR; PG8_MMA(1, 1, At, B1); PG8_BAR;
            }
        }
        if constexpr (ALIGN_EPI) { if (wr == 0) PG8_BAR; }
        if constexpr (!Epi::AFTER_DRAIN) { E(acc, cur, wr, wc, fr, fq); S.done(cur); }
        if (!has_next) break;
#pragma unroll
        for (int a = 0; a < 2; ++a)
#pragma unroll
            for (int b = 0; b < 2; ++b)
#pragma unroll
                for (int m = 0; m < 4; ++m)
#pragma unroll
                    for (int n = 0; n < 2; ++n) acc[a][b][m][n] = acc_t{};
        cur = nxt; cA = nA; cB = nB; ++ui;
        if constexpr (ALIGN_EPI) { if (wr == 1) PG8_BAR; }
    }
    PG8_WAIT_V(0);
    if constexpr (!ALIGN_EPI) { if (wr == 0) PG8_BAR; }
    PG8_BAR;
    if constexpr (Epi::AFTER_DRAIN) { E.fused(acc, cur, wr, wc, fr, fq, lds, wid, lane); S.done(cur); }
#undef PG8_SA
#undef PG8_SB
#undef PG8_STAGE
#undef PG8_LDA
#undef PG8_LDB
#undef PG8_MMA
#undef PG8_WAIT_V
#undef PG8_WAIT_L
#undef PG8_BAR
#undef PG8_SCHED
}
template <int ACT> __device__ __forceinline__ float act_f(float x) {
    if (ACT == 1) return 2.f * __builtin_amdgcn_rcpf(1.f + __expf(-2.f * x)) - 1.f;
    if (ACT == 2) return 1.f * __builtin_amdgcn_rcpf(1.f + __expf(-x));
    if (ACT == 3) return -0.6065306597f * __builtin_amdgcn_rcpf(1.f + __expf(-x));
    return x;
}
template <int ACT> __device__ __forceinline__ void store_tile_bf16(const f32x4 (&acc)[2][2][4][2], bf16_t* base, int ldc, int row0, int col0, const float* bias, int bcol0) {
    f32x4 bv[2][2];
#pragma unroll
    for (int bj = 0; bj < 2; ++bj)
#pragma unroll
        for (int n = 0; n < 2; ++n) bv[bj][n] = bias ? *(const f32x4*)(bias + bcol0 + bj * HALF + 4 * n) : (f32x4){0.f, 0.f, 0.f, 0.f};
#pragma unroll
    for (int ai = 0; ai < 2; ++ai)
#pragma unroll
        for (int m = 0; m < 4; ++m) { bf16_t* rowp = base + (size_t)(row0 + ai * HALF + m * 16) * ldc + col0;
#pragma unroll
            for (int bj = 0; bj < 2; ++bj) { f32x4 v0 = acc[ai][bj][m][0] + bv[bj][0], v1 = acc[ai][bj][m][1] + bv[bj][1];
#pragma unroll
                for (int e = 0; e < 4; ++e) { v0[e] = act_f<ACT>(v0[e]); v1[e] = act_f<ACT>(v1[e]); }
                u32x4 w; w.x = cvt_pk_bf16(v0[0], v0[1]); w.y = cvt_pk_bf16(v0[2], v0[3]); w.z = cvt_pk_bf16(v1[0], v1[1]); w.w = cvt_pk_bf16(v1[2], v1[3]);
                *(u32x4*)(rowp + bj * HALF) = w; } }
}
struct EpiPlain {
    typedef f32x4 acc_t; static constexpr bool PERM = true, AFTER_DRAIN = false;
    bf16_t* O; int ldc;
    __device__ __forceinline__ void operator()(const f32x4 (&acc)[2][2][4][2], const Unit& u, int wr, int wc, int fr, int fq) const {
        store_tile_bf16<0>(acc, O, ldc, u.pm * BM + wr * 64 + fr, u.pn * BM + wc * 32 + 8 * fq, nullptr, 0);
    }
};
struct EpiL0B {
    typedef f32x4 acc_t; static constexpr bool PERM = true, AFTER_DRAIN = false;
    bf16_t* rkv; bf16_t* hl;
    __device__ __forceinline__ void operator()(const f32x4 (&acc)[2][2][4][2], const Unit& u, int wr, int wc, int fr, int fq) const {
        const int j = u.aux, pmL = u.pm - NPANEL * j;
        if (j < 3) { store_tile_bf16<0>(acc, rkv + (size_t)j * SLOT_ELEMS, D, pmL * BM + wr * 64 + fr, (u.pn - 8 * j) * BM + wc * 32 + 8 * fq, nullptr, 0); return; }
        bf16_t* base = hl + (size_t)(j - 3) * S * 256; const int row0 = pmL * BM + wr * 64 + fr, col0 = wc * 32 + 8 * fq;
        if (j == 3) store_tile_bf16<1>(acc, base, 256, row0, col0, nullptr, 0);
        else if (j == 4) store_tile_bf16<0>(acc, base, 256, row0, col0, nullptr, 0);
        else store_tile_bf16<2>(acc, base, 256, row0, col0, nullptr, 0);
    }
};
struct EpiL0C {
    typedef f32x4 acc_t; static constexpr bool PERM = true, AFTER_DRAIN = false;
    bf16_t* out; const float* w0; const float* a0;
    __device__ __forceinline__ void operator()(const f32x4 (&acc)[2][2][4][2], const Unit& u, int wr, int wc, int fr, int fq) const {
        const int p = u.aux, src = p >> 1, pmL = u.pm - NPANEL * src, pnL = u.pn - 8 * p;
        bf16_t* base = out + (size_t)p * SLOT_ELEMS; const int row0 = pmL * BM + wr * 64 + fr, col0 = pnL * BM + wc * 32 + 8 * fq;
        if (p < 2) store_tile_bf16<3>(acc, base, D, row0, col0, w0 + p * D, col0);
        else if (p < 4) store_tile_bf16<2>(acc, base, D, row0, col0, a0 + (p - 2) * D, col0);
        else store_tile_bf16<0>(acc, base, D, row0, col0, nullptr, 0);
    }
};
struct EpiSwiGLU {
    typedef f32x4 acc_t; static constexpr bool PERM = true, AFTER_DRAIN = false;
    bf16_t* O;
    __device__ __forceinline__ void operator()(const f32x4 (&acc)[2][2][4][2], const Unit& u, int wr, int wc, int fr, int fq) const {
        const int row0 = u.pm * BM + wr * 64 + fr, col0 = u.pn * HALF + wc * 32 + 8 * fq;
#pragma unroll
        for (int ai = 0; ai < 2; ++ai)
#pragma unroll
            for (int m = 0; m < 4; ++m) { bf16_t* rowp = O + (size_t)(row0 + ai * HALF + m * 16) * FF + col0;
                float h[8];
#pragma unroll
                for (int n = 0; n < 2; ++n)
#pragma unroll
                    for (int e = 0; e < 4; ++e) { const float g = acc[ai][0][m][n][e], up = acc[ai][1][m][n][e]; h[4 * n + e] = g * up * __builtin_amdgcn_rcpf(1.f + __expf(-g)); }
                u32x4 w; w.x = cvt_pk_bf16(h[0], h[1]); w.y = cvt_pk_bf16(h[2], h[3]); w.z = cvt_pk_bf16(h[4], h[5]); w.w = cvt_pk_bf16(h[6], h[7]);
                *(u32x4*)rowp = w; }
    }
};
struct EpiPleGate {
    typedef f32x4 acc_t; static constexpr bool PERM = false, AFTER_DRAIN = false;
    float* X; const bf16_t* PP;
    __device__ __forceinline__ void operator()(const f32x4 (&acc)[2][2][4][2], const Unit& u, int wr, int wc, int fr, int fq) const {
        const int row0 = u.pm * BM + wr * 64 + fr, col0 = u.pn * BM + wc * 32 + 4 * fq;
#pragma unroll
        for (int ai = 0; ai < 2; ++ai)
#pragma unroll
            for (int m = 0; m < 4; ++m) { const size_t off = (size_t)(row0 + ai * HALF + m * 16) * D + col0;
#pragma unroll
                for (int bj = 0; bj < 2; ++bj)
#pragma unroll
                    for (int n = 0; n < 2; ++n) { const size_t o2 = off + bj * HALF + n * 16; const u32x2 pw = *(const u32x2*)(PP + o2); f32x4 xv = *(const f32x4*)(X + o2); const f32x4 a = acc[ai][bj][m][n];
                        xv[0] += bflo(pw.x) * __builtin_amdgcn_rcpf(1.f + __expf(-a[0])); xv[1] += bfhi(pw.x) * __builtin_amdgcn_rcpf(1.f + __expf(-a[1])); xv[2] += bflo(pw.y) * __builtin_amdgcn_rcpf(1.f + __expf(-a[2])); xv[3] += bfhi(pw.y) * __builtin_amdgcn_rcpf(1.f + __expf(-a[3]));
                        *(f32x4*)(X + o2) = xv; } }
    }
};
struct EpiPlainI8 {
    typedef i32x4 acc_t; static constexpr bool PERM = true, AFTER_DRAIN = false;
    bf16_t* O; int ldc; const float* asc; const float* wsc;
    __device__ __forceinline__ void operator()(const i32x4 (&acc)[2][2][4][2], const Unit& u, int wr, int wc, int fr, int fq) const {
        const int row0 = u.pm * BM + wr * 64 + fr, col0 = u.pn * BM + wc * 32 + 8 * fq;
        f32x4 ws[2][2];
#pragma unroll
        for (int bj = 0; bj < 2; ++bj)
#pragma unroll
            for (int n = 0; n < 2; ++n) ws[bj][n] = *(const f32x4*)(wsc + col0 + bj * HALF + 4 * n);
        float sav[2][4];
#pragma unroll
        for (int ai = 0; ai < 2; ++ai)
#pragma unroll
            for (int m = 0; m < 4; ++m) sav[ai][m] = asc[row0 + ai * HALF + m * 16];
#pragma unroll
        for (int ai = 0; ai < 2; ++ai)
#pragma unroll
            for (int m = 0; m < 4; ++m) { const int row = row0 + ai * HALF + m * 16; const float sa = sav[ai][m]; bf16_t* rowp = O + (size_t)row * ldc + col0;
#pragma unroll
                for (int bj = 0; bj < 2; ++bj) { float v[8];
#pragma unroll
                    for (int n = 0; n < 2; ++n) { const f32x4 sw = ws[bj][n] * sa;
#pragma unroll
                        for (int e = 0; e < 4; ++e) v[4 * n + e] = (float)acc[ai][bj][m][n][e] * sw[e]; }
                    u32x4 w; w.x = cvt_pk_bf16(v[0], v[1]); w.y = cvt_pk_bf16(v[2], v[3]); w.z = cvt_pk_bf16(v[4], v[5]); w.w = cvt_pk_bf16(v[6], v[7]);
                    *(u32x4*)(rowp + bj * HALF) = w; } }
    }
};
struct EpiSwiGLUI8 {
    typedef i32x4 acc_t; static constexpr bool PERM = true, AFTER_DRAIN = false;
    bf16_t* O; const float* asc; const float* wsc;
    __device__ __forceinline__ void operator()(const i32x4 (&acc)[2][2][4][2], const Unit& u, int wr, int wc, int fr, int fq) const {
        const int row0 = u.pm * BM + wr * 64 + fr, col0 = u.pn * HALF + wc * 32 + 8 * fq, bcol0 = u.pn * BM + wc * 32 + 8 * fq;
        f32x4 ws[2][2];
#pragma unroll
        for (int bj = 0; bj < 2; ++bj)
#pragma unroll
            for (int n = 0; n < 2; ++n) ws[bj][n] = *(const f32x4*)(wsc + bcol0 + bj * HALF + 4 * n);
        float sav[2][4];
#pragma unroll
        for (int ai = 0; ai < 2; ++ai)
#pragma unroll
            for (int m = 0; m < 4; ++m) sav[ai][m] = asc[row0 + ai * HALF + m * 16];
#pragma unroll
        for (int ai = 0; ai < 2; ++ai)
#pragma unroll
            for (int m = 0; m < 4; ++m) { const int row = row0 + ai * HALF + m * 16; const float sa = sav[ai][m]; bf16_t* rowp = O + (size_t)row * FF + col0;
                float h[8];
#pragma unroll
                for (int n = 0; n < 2; ++n)
#pragma unroll
                    for (int e = 0; e < 4; ++e) { const float g = (float)acc[ai][0][m][n][e] * (sa * ws[0][n][e]), up = (float)acc[ai][1][m][n][e] * (sa * ws[1][n][e]); h[4 * n + e] = g * up * __builtin_amdgcn_rcpf(1.f + __expf(-g)); }
                u32x4 w; w.x = cvt_pk_bf16(h[0], h[1]); w.y = cvt_pk_bf16(h[2], h[3]); w.z = cvt_pk_bf16(h[4], h[5]); w.w = cvt_pk_bf16(h[6], h[7]);
                *(u32x4*)rowp = w; }
    }
};
struct EpiPleGateI8 {
    typedef i32x4 acc_t; static constexpr bool PERM = false, AFTER_DRAIN = false;
    const bf16_t* XI; bf16_t* XB; float* XF; const bf16_t* PP; const float* asc; const float* wsc;
    __device__ __forceinline__ void operator()(const i32x4 (&acc)[2][2][4][2], const Unit& u, int wr, int wc, int fr, int fq) const {
        const int row0 = u.pm * BM + wr * 64 + fr, col0 = u.pn * BM + wc * 32 + 4 * fq;
        f32x4 ws[2][2];
#pragma unroll
        for (int bj = 0; bj < 2; ++bj)
#pragma unroll
            for (int n = 0; n < 2; ++n) ws[bj][n] = *(const f32x4*)(wsc + col0 + bj * HALF + n * 16);
        float sav[2][4];
#pragma unroll
        for (int ai = 0; ai < 2; ++ai)
#pragma unroll
            for (int m = 0; m < 4; ++m) sav[ai][m] = asc[row0 + ai * HALF + m * 16];
        u32x2 pw[2][4], xw[2][4];
#define GATE_LD(buf, i) do { const size_t off_ = (size_t)(row0 + ((i) >> 2) * HALF + ((i) & 3) * 16) * D + col0; _Pragma("unroll") for (int q_ = 0; q_ < 4; ++q_) { const size_t o2_ = off_ + (q_ >> 1) * HALF + (q_ & 1) * 16; \
            pw[buf][q_] = *(const u32x2*)(PP + o2_); xw[buf][q_] = *(const u32x2*)(XI + o2_); } } while (0)
        GATE_LD(0, 0);
#pragma unroll
        for (int i = 0; i < 8; ++i) { const int ai = i >> 2, m = i & 3; const float sa = sav[ai][m]; const size_t off = (size_t)(row0 + ai * HALF + m * 16) * D + col0;
            if (i + 1 < 8) GATE_LD((i + 1) & 1, i + 1);
#pragma unroll
            for (int q = 0; q < 4; ++q) { const int bj = q >> 1, n = q & 1; const size_t o2 = off + bj * HALF + n * 16; const u32x2 pv = pw[i & 1][q], xq = xw[i & 1][q]; const i32x4 ia = acc[ai][bj][m][n]; const f32x4 wv = ws[bj][n];
                f32x4 xv = (f32x4){bflo(xq.x), bfhi(xq.x), bflo(xq.y), bfhi(xq.y)};
                xv[0] += bflo(pv.x) * __builtin_amdgcn_rcpf(1.f + __expf(-(float)ia[0] * sa * wv[0])); xv[1] += bfhi(pv.x) * __builtin_amdgcn_rcpf(1.f + __expf(-(float)ia[1] * sa * wv[1]));
                xv[2] += bflo(pv.y) * __builtin_amdgcn_rcpf(1.f + __expf(-(float)ia[2] * sa * wv[2])); xv[3] += bfhi(pv.y) * __builtin_amdgcn_rcpf(1.f + __expf(-(float)ia[3] * sa * wv[3]));
                if (XF) *(f32x4*)(XF + o2) = xv; else { u32x2 w; w.x = cvt_pk_bf16(xv[0], xv[1]); w.y = cvt_pk_bf16(xv[2], xv[3]); *(u32x2*)(XB + o2) = w; } } }
#undef GATE_LD
    }
};
struct TabL0B { static constexpr int NP = 6; static __device__ constexpr int nM(int) { return NPANEL; } static __device__ constexpr int nN(int j) { return j < 3 ? 8 : 1; }
    static __device__ constexpr int pm0(int j) { return NPANEL * j; } static __device__ constexpr int pn0(int j) { return j < 3 ? 8 * j : 24 + (j - 3); } };
struct TabL0C { static constexpr int NP = 5; static __device__ constexpr int nM(int) { return NPANEL; } static __device__ constexpr int nN(int) { return 8; }
    static __device__ constexpr int pm0(int p) { return NPANEL * (p >> 1); } static __device__ constexpr int pn0(int p) { return 8 * p; } };
template <int NN> struct TabOne { static constexpr int NP = 1; static __device__ constexpr int nM(int) { return NPANEL; } static __device__ constexpr int nN(int) { return NN; }
    static __device__ constexpr int pm0(int) { return 0; } static __device__ constexpr int pn0(int) { return 0; } };
}
typedef pg8::Unit Unit;
#define XB_TMO      128
#define XB_XCNT(j)  (256  + 64 * (j))
#define XB_XSUB(j)  (1280 + 64 * (j))
#define XB_XGEN(j)  (2304 + 64 * (j))
#define XB_TOP      3328
#define XB_TOPGEN   3392
#define XCD_BAR_WORDS 3456
#define XB_SPIN_CAP (1u << 21)

__device__ __forceinline__ unsigned xb_ld(unsigned* p)              { return __hip_atomic_load(p, __ATOMIC_RELAXED, __HIP_MEMORY_SCOPE_AGENT); }
__device__ __forceinline__ unsigned xb_add(unsigned* p, unsigned v) { return __hip_atomic_fetch_add(p, v, __ATOMIC_RELAXED, __HIP_MEMORY_SCOPE_AGENT); }
__device__ __forceinline__ unsigned xb_xcc_id() { return (unsigned)__builtin_amdgcn_s_getreg((3 << 11) | 20) & 0xFu; }
#define XB_SPIN(cond, bar) do { unsigned _sp = 0; while (cond) { __builtin_amdgcn_s_sleep(1); \
    if ((++_sp & 255u) == 0u) { if (xb_ld(&(bar)[XB_TMO])) break; if (_sp > XB_SPIN_CAP) { atomicAdd(&(bar)[XB_TMO], 1u); break; } } } } while (0)

struct XcdBarrier {
    unsigned* bar; unsigned x;
    volatile LAS unsigned* st;
    int w;
};

__device__ __forceinline__ XcdBarrier xcd_barrier_post(unsigned* bar, volatile LAS unsigned* st) {
    XcdBarrier b; b.bar = bar; b.x = xb_xcc_id(); b.st = st; b.w = 0;
    if (threadIdx.x == 0) (void)xb_add(&bar[XB_XCNT(b.x)], 1u);
    return b;
}
__device__ __forceinline__ void xcd_barrier_complete(unsigned* bar, unsigned x, unsigned& nloc, unsigned& nx) {
    const unsigned G = gridDim.x * gridDim.y * gridDim.z;
    unsigned sum, cnt, mine, sp = 0u;
    for (;;) {
        sum = 0u; cnt = 0u; mine = 0u;
#pragma unroll
        for (unsigned j = 0; j < 16; ++j) { const unsigned c = xb_ld(&bar[XB_XCNT(j)]); sum += c; cnt += (c > 0u) ? 1u : 0u; mine = (j == x) ? c : mine; }
        if (sum == G) break;
        __builtin_amdgcn_s_sleep(1);
        if ((++sp & 255u) == 0u) { if (xb_ld(&bar[XB_TMO])) break; if (sp > XB_SPIN_CAP) { atomicAdd(&bar[XB_TMO], 1u); break; } }
    }
    nloc = mine > 0u ? mine : 1u; nx = cnt > 0u ? cnt : 1u;
}

__device__ __forceinline__ void xcd_barrier(const XcdBarrier& b) {
    asm volatile("s_waitcnt vmcnt(0)" ::: "memory");
    __syncthreads();
    int ln_; asm volatile("v_mbcnt_lo_u32_b32 %0, -1, 0\n\tv_mbcnt_hi_u32_b32 %0, -1, %0" : "=v"(ln_));
    if (b.w == 0 && ln_ == 0) {
        unsigned* bar = b.bar;
        __builtin_amdgcn_s_waitcnt(0);
        unsigned nloc = b.st[0], nx = b.st[1];
        if (nloc == 0u) { xcd_barrier_complete(bar, b.x, nloc, nx); b.st[0] = nloc; b.st[1] = nx; }
        const unsigned old = xb_add(&bar[XB_XSUB(b.x)], 1u);
        const unsigned gen = old / nloc;
        if (old + 1u == (gen + 1u) * nloc) {
            __builtin_amdgcn_fence(__ATOMIC_RELEASE, "agent");
            asm volatile("s_waitcnt vmcnt(0)" ::: "memory");
            const unsigned og = xb_add(&bar[XB_TOP], 1u);
            const unsigned tg = og / nx;
            if (og + 1u == (tg + 1u) * nx) xb_add(&bar[XB_TOPGEN], 1u);
            else XB_SPIN(xb_ld(&bar[XB_TOPGEN]) == tg, bar);
            __builtin_amdgcn_fence(__ATOMIC_ACQUIRE, "agent");
            xb_add(&bar[XB_XGEN(b.x)], 1u);
            asm volatile("s_waitcnt vmcnt(0)" ::: "memory");
        } else {
            XB_SPIN(xb_ld(&bar[XB_XGEN(b.x)]) == gen, bar);
            __builtin_amdgcn_fence(__ATOMIC_ACQUIRE, "agent");
            asm volatile("s_waitcnt vmcnt(0)" ::: "memory");
        }
    }
    __syncthreads();
}
constexpr int NWAVES = 8;
constexpr int RING_BYTES = 131072, LDSCTL_OFF = RING_BYTES, MISC_OFF = LDSCTL_OFF + 320, LDS_BYTES = 147456;
constexpr int CW_BAR = 4096;

struct Args { const float* in[29]; float* out; unsigned char* ws; int slab_lo, slab_hi, ph_lo, ph_hi, use_bar, do_pro; };
typedef const __attribute__((address_space(4))) Args* ArgsP;
DI ArgsP args_ptr() { ArgsP p = (ArgsP)__builtin_amdgcn_kernarg_segment_ptr(); asm volatile("" : "+s"(p)); return p; }

struct Frame {
    LAS unsigned char* lds; unsigned char* ldsg;
    int tid, lane, wave, vcu, G, gw, NGW;
};

DI void wht8(float (&f)[8]) {
#pragma unroll
    for (int st = 4; st >= 1; st >>= 1)
#pragma unroll
        for (int i = 0; i < 8; ++i) if (!(i & st)) { const float a = f[i], b = f[i + st]; f[i] = a + b; f[i + st] = a - b; }
}
DI int w_row(int nn, int rowoff, int mode) { return mode == 1 ? (nn < FF ? 256 * (nn >> 7) + (nn & 127) : 256 * ((nn - FF) >> 7) + 128 + ((nn - FF) & 127)) : rowoff + nn; }
template <bool RANGE, bool I8> DI void tr_job(const float* src, const int K, const int N, const int klo, const int khi, void* dst, const int pitch, const int rowoff, const int mode, const float* wsc,
                                              LAS float* scr, const int gw, const int NGW, const int lane, const int rot = 0, const float* part = nullptr, float* wsc_out = nullptr) {
    const int nblk = N >> 5, nitems = (K >> 6) * nblk, r8 = lane >> 3, c4 = lane & 7, hf = lane >> 5, n = lane & 31;
    f32x4 v[8]; float scn = 0.f;
#define TR_LOAD(it_) do { const int kb_ = (it_) / nblk, nb_ = (it_) - kb_ * nblk; const float* sp_ = src + nb_ * 32 + 4 * c4; \
        _Pragma("unroll") for (int i = 0; i < 8; ++i) { const int kv = kb_ * 64 + 8 * i + r8; \
            if (RANGE) { const bool ok = kv >= klo && kv < khi; const f32x4 t_ = *(const f32x4*)(sp_ + (size_t)(ok ? kv - klo : 0) * N); v[i] = ok ? t_ : (f32x4){0.f, 0.f, 0.f, 0.f}; } \
            else v[i] = *(const f32x4*)(sp_ + (size_t)kv * N); } \
        if (I8) { const int rw_ = w_row(nb_ * 32 + n, rowoff, mode); scn = rot ? fmaxf(fmaxf(part[rw_], part[2048 + rw_]), fmaxf(part[4096 + rw_], part[6144 + rw_])) : wsc[rw_]; } } while (0)
    int it = gw; if (it < nitems) TR_LOAD(it);
    for (; it < nitems; it += NGW) {
#pragma unroll
        for (int i = 0; i < 8; ++i) *(LAS f32x4*)(scr + (8 * i + r8) * 36 + 4 * c4) = v[i];
        const float sc = scn; const int kb = it / nblk, nb = it - kb * nblk;
        if (it + NGW < nitems) TR_LOAD(it + NGW);
        LDS_WAIT(); asm volatile("" ::: "memory");
        const int row = w_row(nb * 32 + n, rowoff, mode);
        if (I8 && rot && kb == 0 && hf == 0) wsc_out[row] = sc;
        const LAS float* sp = scr + (32 * hf) * 36 + n;
        float f[32];
#pragma unroll
        for (int j = 0; j < 32; ++j) f[j] = sp[j * 36];
        if (I8 && rot) {
#pragma unroll
            for (int q = 0; q < 4; ++q) { float t[8];
#pragma unroll
                for (int e = 0; e < 8; ++e) t[e] = f[8 * q + e];
                wht8(t);
#pragma unroll
                for (int e = 0; e < 8; ++e) f[8 * q + e] = t[e]; }
#pragma unroll
            for (int q = 0; q < 2; ++q)
#pragma unroll
                for (int e = 0; e < 8; ++e) { const float a = f[16 * q + e], b = f[16 * q + 8 + e]; f[16 * q + e] = a + b; f[16 * q + 8 + e] = a - b; }
#pragma unroll
            for (int j = 0; j < 16; ++j) { const float a = f[j], b = f[j + 16]; f[j] = (a + b) * 0.03125f; f[j + 16] = (a - b) * 0.03125f; } }
        if (I8) { const float inv = sc > 0.f ? 1.f / sc : 0.f; u32x4 o[2];
#pragma unroll
            for (int q = 0; q < 2; ++q) { o[q].x = pack4_i8(f[16 * q] * inv, f[16 * q + 1] * inv, f[16 * q + 2] * inv, f[16 * q + 3] * inv); o[q].y = pack4_i8(f[16 * q + 4] * inv, f[16 * q + 5] * inv, f[16 * q + 6] * inv, f[16 * q + 7] * inv);
                o[q].z = pack4_i8(f[16 * q + 8] * inv, f[16 * q + 9] * inv, f[16 * q + 10] * inv, f[16 * q + 11] * inv); o[q].w = pack4_i8(f[16 * q + 12] * inv, f[16 * q + 13] * inv, f[16 * q + 14] * inv, f[16 * q + 15] * inv); }
            unsigned char* d = (unsigned char*)dst + (size_t)row * pitch + kb * 64 + 32 * hf; *(u32x4*)d = o[0]; *(u32x4*)(d + 16) = o[1]; }
        else { bf16* d = (bf16*)dst + (size_t)row * pitch + kb * 64 + 32 * hf;
#pragma unroll
            for (int q = 0; q < 4; ++q) { u32x4 o; o.x = cvt_pk_bf16(f[8 * q], f[8 * q + 1]); o.y = cvt_pk_bf16(f[8 * q + 2], f[8 * q + 3]); o.z = cvt_pk_bf16(f[8 * q + 4], f[8 * q + 5]); o.w = cvt_pk_bf16(f[8 * q + 6], f[8 * q + 7]); *(u32x4*)(d + 8 * q) = o; } }
        LDS_WAIT(); asm volatile("" ::: "memory");
    }
#undef TR_LOAD
}
DI void col_absmax_strip(const float* src, int K, int N, int rowoff, int mode, float* wsc, int strip, int lane) {
    const int n0 = strip * 32, r8 = lane >> 3, c4 = lane & 7; const float* sp = src + n0 + 4 * c4;
    f32x4 m = (f32x4){0.f, 0.f, 0.f, 0.f};
    f32x4 cur[8];
#pragma unroll
    for (int i = 0; i < 8; ++i) cur[i] = *(const f32x4*)(sp + (size_t)(r8 + 8 * i) * N);
    for (int k = r8; k < K; k += 64) { f32x4 nxt[8]; const bool more = k + 64 < K;
        if (more) {
#pragma unroll
            for (int i = 0; i < 8; ++i) nxt[i] = *(const f32x4*)(sp + (size_t)(k + 64 + 8 * i) * N); }
#pragma unroll
        for (int i = 0; i < 8; ++i)
#pragma unroll
            for (int e = 0; e < 4; ++e) m[e] = fmaxf(m[e], fabsf(cur[i][e]));
        if (more) {
#pragma unroll
            for (int i = 0; i < 8; ++i) cur[i] = nxt[i]; } }
#pragma unroll
    for (int e = 0; e < 4; ++e) { float x = m[e]; x = fmaxf(x, dpp_mov<DPP_MIRROR>(dpp_mov<DPP_HMIRROR>(x))); m[e] = rows_max(x); }
    if (lane < 8) {
#pragma unroll
        for (int e = 0; e < 4; ++e) wsc[w_row(n0 + 4 * lane + e, rowoff, mode)] = m[e] * (1.f / 127.f); }
}
DI void col_absmax_strip_rot(const float* src_, int K, int N, int rowoff, int mode, float* wsc, int strip, int lane, int kbeg) {
    const float* src = src_ + (size_t)kbeg * N;
    const int n0 = strip * 32, r8 = lane >> 3, c4 = lane & 7; const float* sp = src + n0 + 4 * c4 + (size_t)(8 * r8) * N;
    f32x4 m = (f32x4){0.f, 0.f, 0.f, 0.f}; const float sg2 = (r8 & 1) ? -1.f : 1.f, sg4 = (r8 & 2) ? -1.f : 1.f;
    f32x4 cur[8];
#pragma unroll
    for (int i = 0; i < 8; ++i) cur[i] = *(const f32x4*)(sp + (size_t)i * N);
    for (int k = 0; k < K; k += 64) { f32x4 nxt[8]; const bool more = k + 64 < K;
        if (more) {
#pragma unroll
            for (int i = 0; i < 8; ++i) nxt[i] = *(const f32x4*)(sp + (size_t)(k + 64 + i) * N); }
#pragma unroll
        for (int e = 0; e < 4; ++e) { float t[8];
#pragma unroll
            for (int i = 0; i < 8; ++i) t[i] = cur[i][e];
            wht8(t);
#pragma unroll
            for (int i = 0; i < 8; ++i) { const float pr = dpp_mov<DPP_MIRROR>(dpp_mov<DPP_HMIRROR>(t[i])); const float v1 = __builtin_fmaf(t[i], sg2, pr);
                const unsigned own = __float_as_uint(v1); const auto sw = __builtin_amdgcn_permlane16_swap(own, own, false, false); const float p16 = __uint_as_float(sw[0] == own ? sw[1] : sw[0]);
                m[e] = fmaxf(m[e], fabsf(__builtin_fmaf(v1, sg4, p16))); } }
        if (more) {
#pragma unroll
            for (int i = 0; i < 8; ++i) cur[i] = nxt[i]; } }
#pragma unroll
    for (int e = 0; e < 4; ++e) { float x = m[e] * 0.03125f; x = fmaxf(x, dpp_mov<DPP_MIRROR>(dpp_mov<DPP_HMIRROR>(x))); m[e] = rows_max(x); }
    if (lane < 8) {
#pragma unroll
        for (int e = 0; e < 4; ++e) wsc[w_row(n0 + 4 * lane + e, rowoff, mode)] = m[e] * (1.f / 127.f); }
}
struct Job { const float* src; int K, N, klo, khi; bf16* dst; int pitch, rowoff, mode, range, i8, rot; float* wsc; float* part; };
constexpr int NJOBS = 24;
DI Job get_job(int j, ArgsP ap) {
    unsigned char* ws = ap->ws; Job b; b.klo = 0; b.mode = 0; b.range = 0; b.rowoff = 0; b.i8 = 0; b.rot = 0; b.wsc = nullptr; b.part = nullptr; float* WSC = (float*)(ws + WS_WSC);
    bf16* WB0 = (bf16*)(ws + WS_WB0); bf16* WL2 = (bf16*)(ws + WS_WL2);
    if (j < 3) { b.src = ap->in[7] + (size_t)j * D * D; b.K = D; b.N = D; b.dst = WB0; b.pitch = D; b.rowoff = D * j; }
    else if (j < 5) { const int d = j - 3; b.src = ap->in[9] + (size_t)d * D * 96; b.K = D; b.N = 96; b.dst = WB0; b.pitch = D; b.rowoff = 6144 + 96 * d; }
    else if (j < 7) { const int d = j - 5; b.src = ap->in[12] + (size_t)d * D * 96; b.K = D; b.N = 96; b.dst = WB0; b.pitch = D; b.rowoff = 6144 + 256 + 96 * d; }
    else if (j == 7) { b.src = ap->in[14]; b.K = D; b.N = 256; b.dst = WB0; b.pitch = D; b.rowoff = 6144 + 512; }
    else if (j < 10) { const int d = j - 8; b.src = ap->in[10] + (size_t)d * 96 * D; b.K = 256; b.N = D; b.klo = 96 * d; b.range = 1; b.dst = WL2 + (size_t)d * D * 256; b.pitch = 256; }
    else if (j < 12) { const int d = j - 10; b.src = ap->in[13] + (size_t)d * 96 * D; b.K = 256; b.N = D; b.klo = 96 * d; b.range = 1; b.dst = WL2 + (size_t)(2 + d) * D * 256; b.pitch = 256; }
    else if (j == 12) { b.src = ap->in[15]; b.K = 256; b.N = D; b.dst = WL2 + (size_t)4 * D * 256; b.pitch = 256; }
    else if (j == 13) { b.src = ap->in[21]; b.K = D; b.N = D; b.dst = (bf16*)(ws + WS_WO0); b.pitch = D; b.i8 = 1; b.rot = 1; b.wsc = WSC + WSC_WO; b.part = WSC + WSC_DN + 4096 + 16384; }
    else if (j == 14) { b.src = ap->in[22]; b.K = D; b.N = NQKV; b.dst = (bf16*)(ws + WS_WQKV); b.pitch = D; b.i8 = 1; b.wsc = WSC + WSC_QKV; }
    else if (j == 15) { b.src = ap->in[23]; b.K = D; b.N = D; b.dst = (bf16*)(ws + WS_WO1); b.pitch = D; b.i8 = 1; b.wsc = WSC + WSC_WO + D; }
    else if (j < 18) { const int l = j - 16; b.src = ap->in[24] + (size_t)l * D * 2 * FF; b.K = D; b.N = 2 * FF; b.dst = (bf16*)(ws + WS_WGU) + (size_t)l * FF * D  ; b.pitch = D; b.mode = 1; b.i8 = 1; b.wsc = WSC + WSC_GU + l * 2 * FF; }
    else if (j < 20) { const int l = j - 18; b.src = ap->in[25] + (size_t)l * FF * D; b.K = FF; b.N = D; b.dst = (bf16*)(ws + WS_WDN) + (size_t)l * D * FF; b.pitch = FF; b.i8 = 1; b.rot = 1; b.wsc = WSC + WSC_DN + (l ? 0 : 2048); b.part = WSC + WSC_DN + 4096 + (l ? 0 : 8192); }
    else if (j < 22) { const int l = j - 20; b.src = ap->in[27] + (size_t)l * D * D; b.K = D; b.N = D; b.dst = (bf16*)(ws + WS_WPG) + (size_t)l * D * D / 2  ; b.pitch = D; b.i8 = 1; b.wsc = WSC + WSC_PG + l * D; }
    else { const int l = j - 22; b.src = ap->in[28] + (size_t)l * PLE * D; b.K = PLE; b.N = D; b.dst = (bf16*)(ws + WS_WPP) + (size_t)l * D * PLE; b.pitch = PLE; }
    b.khi = b.range ? b.klo + 96 : b.K;
    return b;
}
DI int t5_bucket(int rel) {
    const int ret = rel > 0 ? 16 : 0; const int n = rel < 0 ? -rel : rel;
    if (n < 8) return ret + n;
    int large = 8 + (int)(logf((float)n / 8.f) / logf(128.f) * 8.f); large = large < 15 ? large : 15;
    return ret + large;
}
DI int job_order(int i) { return i < 4 ? 14 + i : (i < 6 ? 16 + i : (i == 6 ? 19 : (i == 7 ? 18 : (i == 8 ? 13 : (i < 22 ? i - 9 : i))))); }
DI void p0_scales(const Frame& F) {
    int base = 0;
    for (int i = 8; i >= 0; --i) {
        const Job b = get_job(job_order(i), args_ptr());
        if (!b.i8) continue;
        const int ns = b.rot ? (b.N >> 5) * 4 : (b.N >> 5); int g0 = F.gw - base % F.NGW; g0 += g0 < 0 ? F.NGW : 0;
        if (b.rot) { for (int it = g0; it < ns; it += F.NGW) col_absmax_strip_rot(b.src, b.K >> 2, b.N, b.rowoff, b.mode, b.part + (it & 3) * 2048, it >> 2, F.lane, (it & 3) * (b.K >> 2)); }
        else for (int st = g0; st < ns; st += F.NGW) col_absmax_strip(b.src, b.K, b.N, b.rowoff, b.mode, b.wsc, st, F.lane);
        base += ns;
    }
}
DI void p0_prologue(const Frame& F) {
    LAS float* scr = (LAS float*)(F.lds + F.wave * 9216);
    int base = 0;
    for (int i = 0; i < NJOBS; ++i) {
        const Job b = get_job(job_order(i), args_ptr());
        int g0 = F.gw - base % F.NGW; g0 += g0 < 0 ? F.NGW : 0;
        if (b.i8) tr_job<false, true>(b.src, b.K, b.N, b.klo, b.khi, b.dst, b.pitch, b.rowoff, b.mode, b.wsc, scr, g0, F.NGW, F.lane, b.rot, b.part, b.wsc);
        else if (b.range) tr_job<true, false>(b.src, b.K, b.N, b.klo, b.khi, b.dst, b.pitch, b.rowoff, b.mode, b.wsc, scr, g0, F.NGW, F.lane);
        else tr_job<false, false>(b.src, b.K, b.N, b.klo, b.khi, b.dst, b.pitch, b.rowoff, b.mode, b.wsc, scr, g0, F.NGW, F.lane);
        base += (b.K >> 6) * (b.N >> 5);
    }
    { ArgsP ap = args_ptr(); bf16* WB0 = (bf16*)(ap->ws + WS_WB0); const int gt = F.vcu * 512 + F.tid, NT = F.G * 512;
      for (int i = gt; i < 2 * 64 * D / 8; i += NT) { const int blk = i / (64 * D / 8), r = i % (64 * D / 8); *(u32x4*)(WB0 + (size_t)(6144 + 256 * blk + 192) * D + (size_t)r * 8) = (u32x4){0u, 0u, 0u, 0u}; }
      float* bt = (float*)(ap->ws + WS_BIAS); const float* tab = ap->in[5];
      for (int i = gt; i < 3 * 16 * 129; i += NT) { const int o = i % 129 - 64, gh = i / 129, gi = gh >> 4; const int dil = gi == 0 ? 1 : (gi == 1 ? 4 : 16);
          bt[i] = tab[t5_bucket(dil * o) * 48 + gh]; } }
}

DI void phase_mix(const Frame& F, const float* x, int Tseq, const float* g, const float* mu, bf16* xs) {
    for (int blk = F.gw; blk < S / 8; blk += F.NGW) {
        const int t0 = blk * 8;
        const bool has_prev = (t0 % Tseq) != 0, has_next = ((t0 + 8) % Tseq) != 0;
        float rs[10];
#pragma unroll
        for (int i = 0; i < 10; ++i) {
            int t = t0 - 1 + i; const bool ok = (i == 0) ? has_prev : ((i == 9) ? has_next : true); t = ok ? t : t0;
            const f32x4* xr = (const f32x4*)(x + (size_t)t * D) + F.lane; float s = 0.f;
#pragma unroll
            for (int jj = 0; jj < 8; ++jj) { const f32x4 v = xr[64 * jj]; s += (v.x * v.x + v.y * v.y) + (v.z * v.z + v.w * v.w); }
            s = wave_sum(s); rs[i] = ok ? rsqrt_fast(s * (1.f / D) + NORM_EPS) : 0.f;
        }
        const int tp = has_prev ? t0 - 1 : t0, tn = has_next ? t0 + 8 : t0;
#pragma unroll 1
        for (int jj = 0; jj < 8; ++jj) {
            const int col = 256 * jj + 4 * F.lane;
            const f32x4 g4 = *(const f32x4*)(g + col);
            f32x4 m4[6];
#pragma unroll
            for (int j = 0; j < 6; ++j) m4[j] = *(const f32x4*)(mu + j * D + col);
            f32x4 hp = *(const f32x4*)(x + (size_t)tp * D + col) * rs[0] * g4;
            f32x4 hc = *(const f32x4*)(x + (size_t)t0 * D + col) * rs[1] * g4;
#pragma unroll
            for (int i = 0; i < 8; ++i) {
                const int tt = (i == 7) ? tn : t0 + i + 1;
                const f32x4 hn = *(const f32x4*)(x + (size_t)tt * D + col) * rs[i + 2] * g4;
                const f32x4 xx = (hp + hn) * 0.5f - hc;
#pragma unroll
                for (int j = 0; j < 6; ++j) { const f32x4 o = hc + xx * m4[j]; u32x2 w; w.x = cvt_pk_bf16(o.x, o.y); w.y = cvt_pk_bf16(o.z, o.w);
                    *(u32x2*)(xs + (size_t)j * SLOT_ELEMS + (size_t)(t0 + i) * D + col) = w; }
                hp = hc; hc = hn;
            }
        }
    }
}
template <bool HAS_O, bool XF32> DI void phase_resnorm(const Frame& F, const void* xold_, bf16* xnew, const bf16* o, const float* ga, const float* gb, unsigned char* hout, float* asc, const float* p, bf16* pb) {
    for (int row = F.gw; row < S; row += F.NGW) {
        f32x4 xv[8];
#pragma unroll
        for (int jj = 0; jj < 4; ++jj) {
            if (XF32) { const f32x4* xr = (const f32x4*)((const float*)xold_ + (size_t)row * D + 512 * jj + 8 * F.lane); xv[2 * jj] = xr[0]; xv[2 * jj + 1] = xr[1]; }
            else { const u32x4 w = *(const u32x4*)((const bf16*)xold_ + (size_t)row * D + 512 * jj + 8 * F.lane);
                xv[2 * jj] = (f32x4){bflo(w.x), bfhi(w.x), bflo(w.y), bfhi(w.y)}; xv[2 * jj + 1] = (f32x4){bflo(w.z), bfhi(w.z), bflo(w.w), bfhi(w.w)}; } }
        if (HAS_O) {
            float ov[32]; float s = 0.f;
#pragma unroll
            for (int jj = 0; jj < 4; ++jj) { const u32x4 w = *(const u32x4*)(o + (size_t)row * D + 512 * jj + 8 * F.lane);
                ov[8 * jj + 0] = bflo(w.x); ov[8 * jj + 1] = bfhi(w.x); ov[8 * jj + 2] = bflo(w.y); ov[8 * jj + 3] = bfhi(w.y); ov[8 * jj + 4] = bflo(w.z); ov[8 * jj + 5] = bfhi(w.z); ov[8 * jj + 6] = bflo(w.w); ov[8 * jj + 7] = bfhi(w.w); }
#pragma unroll
            for (int e = 0; e < 32; ++e) s += ov[e] * ov[e];
            s = wave_sum(s); const float rstd = rsqrt_fast(s * (1.f / D) + NORM_EPS);
#pragma unroll
            for (int jj = 0; jj < 4; ++jj) { const f32x4* gr = (const f32x4*)(ga + 512 * jj + 8 * F.lane); const f32x4 g0 = gr[0], g1 = gr[1];
#pragma unroll
                for (int e = 0; e < 4; ++e) { xv[2 * jj][e] += ov[8 * jj + e] * rstd * g0[e]; xv[2 * jj + 1][e] += ov[8 * jj + 4 + e] * rstd * g1[e]; } }
#pragma unroll
            for (int jj = 0; jj < 4; ++jj) { u32x4 w; w.x = cvt_pk_bf16(xv[2 * jj].x, xv[2 * jj].y); w.y = cvt_pk_bf16(xv[2 * jj].z, xv[2 * jj].w); w.z = cvt_pk_bf16(xv[2 * jj + 1].x, xv[2 * jj + 1].y); w.w = cvt_pk_bf16(xv[2 * jj + 1].z, xv[2 * jj + 1].w);
                *(u32x4*)(xnew + (size_t)row * D + 512 * jj + 8 * F.lane) = w; }
        }
        float s2 = 0.f;
#pragma unroll
        for (int q = 0; q < 8; ++q) s2 += (xv[q].x * xv[q].x + xv[q].y * xv[q].y) + (xv[q].z * xv[q].z + xv[q].w * xv[q].w);
        s2 = wave_sum(s2); const float rstd2 = rsqrt_fast(s2 * (1.f / D) + NORM_EPS);
        float mx = 0.f;
#pragma unroll
        for (int jj = 0; jj < 4; ++jj) { const f32x4* gr = (const f32x4*)(gb + 512 * jj + 8 * F.lane); xv[2 * jj] = xv[2 * jj] * rstd2 * gr[0]; xv[2 * jj + 1] = xv[2 * jj + 1] * rstd2 * gr[1];
#pragma unroll
            for (int e = 0; e < 4; ++e) mx = fmaxf(mx, fmaxf(fabsf(xv[2 * jj][e]), fabsf(xv[2 * jj + 1][e]))); }
        mx = wave_max(mx); const float inv = mx > 0.f ? 127.f / mx : 0.f;
#pragma unroll
        for (int jj = 0; jj < 4; ++jj) { const f32x4 a = xv[2 * jj] * inv, b = xv[2 * jj + 1] * inv; u32x2 w; w.x = pack4_i8(a.x, a.y, a.z, a.w); w.y = pack4_i8(b.x, b.y, b.z, b.w);
            *(u32x2*)(hout + (size_t)row * D + 512 * jj + 8 * F.lane) = w; }
        if (F.lane == 0) asc[row] = mx * (1.f / 127.f);
        if (p) { const f32x4 pv = *(const f32x4*)(p + (size_t)row * PLE + 4 * F.lane); u32x2 w; w.x = cvt_pk_bf16(pv.x, pv.y); w.y = cvt_pk_bf16(pv.z, pv.w); *(u32x2*)(pb + (size_t)row * PLE + 4 * F.lane) = w; }
    }
}
DI void unpack8(const u32x4 w, float (&f)[8]) { f[0] = bflo(w.x); f[1] = bfhi(w.x); f[2] = bflo(w.y); f[3] = bfhi(w.y); f[4] = bflo(w.z); f[5] = bfhi(w.z); f[6] = bflo(w.w); f[7] = bfhi(w.w); }
DI void phase_quant_hidden(const Frame& F, const bf16* hid, unsigned char* out, float* asc) {
    for (int row = F.gw; row < S; row += F.NGW) {
        u32x4 w[11]; float mx = 0.f;
#pragma unroll
        for (int c = 0; c < 11; ++c) w[c] = *(const u32x4*)(hid + (size_t)row * FF + (c * 64 + F.lane) * 8);
        const float sg2 = (F.lane & 1) ? -1.f : 1.f, sg4 = (F.lane & 2) ? -1.f : 1.f;
#pragma unroll
        for (int c = 0; c < 11; ++c) { float f[8]; unpack8(w[c], f); wht8(f);
#pragma unroll
            for (int e = 0; e < 8; ++e) { f[e] = __builtin_fmaf(f[e], sg2, dpp_mov<DPP_XOR1>(f[e])); f[e] = __builtin_fmaf(f[e], sg4, dpp_mov<DPP_XOR2>(f[e])); mx = fmaxf(mx, fabsf(f[e])); } }
        mx = wave_max(mx); const float inv = mx > 0.f ? 127.f / mx : 0.f;
#pragma unroll
        for (int c = 0; c < 11; ++c) { float f[8]; unpack8(w[c], f); wht8(f);
#pragma unroll
            for (int e = 0; e < 8; ++e) { f[e] = __builtin_fmaf(f[e], sg2, dpp_mov<DPP_XOR1>(f[e])); f[e] = __builtin_fmaf(f[e], sg4, dpp_mov<DPP_XOR2>(f[e])); }
            u32x2 o; o.x = pack4_i8(f[0] * inv, f[1] * inv, f[2] * inv, f[3] * inv); o.y = pack4_i8(f[4] * inv, f[5] * inv, f[6] * inv, f[7] * inv);
            *(u32x2*)(out + (size_t)row * FF + (c * 64 + F.lane) * 8) = o; }
        if (F.lane == 0) asc[row] = mx * (1.f / 127.f);
    }
}
DI void phase_post(const Frame& F, const bf16* y0, const bf16* y1, const bf16* v, const bf16* g, const float* BON, const float* lnx_g, const float* lnx_b, unsigned char* out, float* asc) {
    const float sg2 = (F.lane & 1) ? -1.f : 1.f, sg4 = (F.lane & 2) ? -1.f : 1.f;
    for (int row = F.gw; row < S; row += F.NGW) {
        float o[4][8]; float mx = 0.f;
#pragma unroll
        for (int jj = 0; jj < 4; ++jj) {
            const size_t e0 = (size_t)row * D + 512 * jj + 8 * F.lane; const int c0 = 512 * jj + 8 * F.lane;
            float fy0[8], fy1[8], fv[8], fg[8];
            unpack8(*(const u32x4*)(y0 + e0), fy0); unpack8(*(const u32x4*)(y1 + e0), fy1); unpack8(*(const u32x4*)(v + e0), fv); unpack8(*(const u32x4*)(g + e0), fg);
            const float bs = 0.5f * (BON[(size_t)row * 32 + (c0 >> 6)] + BON[(size_t)S * 32 + (size_t)row * 32 + (c0 >> 6)]);
            float lg[8], lb[8];
            *(f32x4*)&lg[0] = *(const f32x4*)(lnx_g + c0); *(f32x4*)&lg[4] = *(const f32x4*)(lnx_g + c0 + 4); *(f32x4*)&lb[0] = *(const f32x4*)(lnx_b + c0); *(f32x4*)&lb[4] = *(const f32x4*)(lnx_b + c0 + 4);
            float y[8], s = 0.f;
#pragma unroll
            for (int e = 0; e < 8; ++e) { y[e] = fy0[e] + fy1[e]; s += y[e]; }
            s = oct_sum(s);
            const float mean = s * (1.f / 64.f); float q = 0.f;
#pragma unroll
            for (int e = 0; e < 8; ++e) { y[e] -= mean; q += y[e] * y[e]; }
            q = oct_sum(q);
            const float rstd = rsqrt_fast(q * (1.f / 64.f) + GN_EPS);
            float t[8];
#pragma unroll
            for (int e = 0; e < 8; ++e) t[e] = (y[e] * rstd * lg[e] + lb[e] + bs * fv[e]) * fg[e];
            wht8(t);
#pragma unroll
            for (int e = 0; e < 8; ++e) { float x = __builtin_fmaf(t[e], sg2, dpp_mov<DPP_XOR1>(t[e])); x = __builtin_fmaf(x, sg4, dpp_mov<DPP_XOR2>(x)); o[jj][e] = x; mx = fmaxf(mx, fabsf(x)); }
            asm volatile("" ::: "memory");
        }
        mx = wave_max(mx); const float qi = mx > 0.f ? 127.f / mx : 0.f;
#pragma unroll
        for (int jj = 0; jj < 4; ++jj) { u32x2 w; w.x = pack4_i8(o[jj][0] * qi, o[jj][1] * qi, o[jj][2] * qi, o[jj][3] * qi); w.y = pack4_i8(o[jj][4] * qi, o[jj][5] * qi, o[jj][6] * qi, o[jj][7] * qi);
            *(u32x2*)(out + (size_t)row * D + 512 * jj + 8 * F.lane) = w; }
        if (F.lane == 0) asc[row] = mx * (1.f / 127.f);
    }
}
constexpr int WK_A = 0, WK_R = 4608, WK_B = 9216, WK_K = 13824, WK_BH = 18432, WK_KH = 23552, WK_VT = 28672,
              WK_TT = 33792, WK_AAK = 36352, WK_ARB = 38912, WK_ARK = 41472, WK_A10 = 44032  ,
              WK_RAW = 44544  , WK_GROUP = 65536,
              WK_SMALL = 131072 + 1024  ;
constexpr int ST64 = 144, ST32 = 80;
DI bf16x8 frag_nat(const LAS unsigned char* p) { return *(const LAS bf16x8*)p; }
DI bf16x8 frag_perm(const LAS unsigned char* p) { const s16x4 lo = *(const LAS s16x4*)p, hi = *(const LAS s16x4*)(p + 32); return (bf16x8){lo[0], lo[1], lo[2], lo[3], hi[0], hi[1], hi[2], hi[3]}; }
DI bf16x8 pack_acc(const f32x4& a, const f32x4& b) { u32x4 w; w.x = cvt_pk_bf16(a[0], a[1]); w.y = cvt_pk_bf16(a[2], a[3]); w.z = cvt_pk_bf16(b[0], b[1]); w.w = cvt_pk_bf16(b[2], b[3]); return __builtin_bit_cast(bf16x8, w); }
#define MFMA16(a, b, c) __builtin_amdgcn_mfma_f32_16x16x32_bf16((a), (b), (c), 0, 0, 0)

template <int MODE> DI void phase_wkv(const Frame& F, int nseq, const bf16* R, const bf16* K, const bf16* V, const bf16* LW, const float* k_k, const float* k_a, const float* r_k, bf16* Y, float* PT, bf16* MB, float* BON) {
    const int lane = F.lane, l15 = lane & 15, g = lane >> 4, wq = F.wave & 3, grp = F.wave >> 2, tg = F.tid & 255;
    const int Tseq = S / nseq;
    LAS unsigned char* gb = F.lds + grp * WK_GROUP;
    LAS float* CWP = (LAS float*)(F.lds + WK_SMALL + grp * 1280); LAS float* WC = CWP + 256;
    const f32x4 zero4 = (f32x4){0.f, 0.f, 0.f, 0.f};
    for (int task = F.vcu * 2 + grp; task < 512; task += F.G * 2) {
        int seq, head, dir, seg;
        if (nseq == 8) { seq = task >> 6; head = (task >> 1) & 31; dir = task & 1; seg = 0; }
        else { const int chain = task >> 3; seq = 0; head = chain >> 1; dir = chain & 1; seg = task & 7; }
        const size_t seqbase = (size_t)seq * Tseq;
        const bf16* lwp = LW + (size_t)dir * SLOT_ELEMS; const bf16* alp = LW + (size_t)(2 + dir) * SLOT_ELEMS; bf16* yo = Y + (size_t)dir * SLOT_ELEMS;
        const int hc = head * 64;
        const float kkw = k_k[hc + lane], kaw = k_a[hc + lane], rkw = r_k[hc + lane];
        float* bon = BON + (size_t)dir * S * 32 + head;
        f32x4 st[4], sid[4];
#pragma unroll
        for (int m = 0; m < 4; ++m) { st[m] = zero4;
#pragma unroll
            for (int e = 0; e < 4; ++e) sid[m][e] = (16 * m + 4 * g + e == 16 * wq + l15) ? 1.f : 0.f; }
        if (MODE == 0 && seg > 0) {
            for (int j = 0; j < seg; ++j) {
                const float* Pi = PT + (size_t)((task & ~7) + j) * 8192; const float* Th = Pi + 4096;
                bf16x8 sf[2]; sf[0] = pack_acc(st[0], st[1]); sf[1] = pack_acc(st[2], st[3]);
#pragma unroll
                for (int m = 0; m < 4; ++m) { f32x4 nw;
#pragma unroll
                    for (int e = 0; e < 4; ++e) nw[e] = Th[(16 * m + 4 * g + e) * 64 + 16 * wq + l15];
#pragma unroll
                    for (int ks = 0; ks < 2; ++ks) { const float* pr = Pi + (16 * m + l15) * 64 + 32 * ks + 4 * g; const f32x4 lo = *(const f32x4*)pr, hi = *(const f32x4*)(pr + 16);
                        nw = MFMA16(pack_acc(lo, hi), sf[ks], nw); }
                    st[m] = nw; }
            }
        }
        u32x4 raw[5];
#define WK_LOAD(ch) do { const int sg = seg * 2048 + (ch) * 32 + (tg >> 3), t = dir ? Tseq - 1 - sg : sg; const size_t el = (seqbase + t) * D + hc + 8 * (tg & 7); \
            raw[0] = *(const u32x4*)(R + el); raw[1] = *(const u32x4*)(K + el); raw[2] = *(const u32x4*)(V + el); raw[3] = *(const u32x4*)(lwp + el); raw[4] = *(const u32x4*)(alp + el); } while (0)
        WK_LOAD(0);
#pragma unroll
        for (int x = 0; x < 5; ++x) *(LAS u32x4*)(gb + WK_RAW + x * 4096 + tg * 16) = raw[x];
        WK_LOAD(1);
        __syncthreads();
#pragma unroll 1
        for (int ch = 0; ch < 64; ++ch) {
            int ln_ = F.lane; if (MODE != 0) asm volatile("" : "+v"(ln_)); const int lane = ln_, l15 = ln_ & 15, g = ln_ >> 4; const int tg = (F.tid & 192) | ln_;
            unsigned short r8[8], k8[8], v8[8], w8[8], a8[8];
            {
              LAS unsigned char* rp = gb + WK_RAW + (8 * wq + ((lane >> 2) & 3)) * 128 + ((lane >> 4) * 16 + (lane & 3) * 4) * 2;
#define WK_TR(dst, x) do { const s16x4 lo_ = __builtin_amdgcn_ds_read_tr16_b64_v4i16((LAS s16x4*)(rp + (x) * 4096)), hi_ = __builtin_amdgcn_ds_read_tr16_b64_v4i16((LAS s16x4*)(rp + (x) * 4096 + 512)); \
                  _Pragma("unroll") for (int q_ = 0; q_ < 4; ++q_) { dst[q_] = (unsigned short)lo_[q_]; dst[4 + q_] = (unsigned short)hi_[q_]; } } while (0)
              WK_TR(r8, 0); WK_TR(k8, 1); WK_TR(v8, 2); WK_TR(w8, 3); WK_TR(a8, 4);
#undef WK_TR
            }
            float lwf[8], cl[8]; float run = 0.f;
#pragma unroll
            for (int e = 0; e < 8; ++e) { lwf[e] = bf2f(w8[e]); run += lwf[e]; cl[e] = run; }
            CWP[wq * 64 + lane] = run;
            __syncthreads();
            const float p0 = CWP[lane], p1 = CWP[64 + lane], p2 = CWP[128 + lane], p3 = CWP[192 + lane];
            const float cwC = (p0 + p1) + (p2 + p3);
            const float pre = (wq > 0 ? p0 : 0.f) + (wq > 1 ? p1 : 0.f) + (wq > 2 ? p2 : 0.f);
            if (ch + 1 < 64) {
#pragma unroll
                for (int x = 0; x < 5; ++x) *(LAS u32x4*)(gb + WK_RAW + x * 4096 + tg * 16) = raw[x]; }
            const float expC = __expf(cwC);
            float bh8[8], kh8[8], sq[8], bn[8]; float ePrev = __expf(pre);
#pragma unroll
            for (int e = 0; e < 8; ++e) { const float kkr = bf2f(k8[e]) * kkw; sq[e] = kkr * kkr; }
            const int ssw = __float_as_int(wave_sum8(sq, lane));
#pragma unroll
            for (int e = 0; e < 8; ++e) {
                const int s = 8 * wq + e; const float kf = bf2f(k8[e]), rf = bf2f(r8[e]), al = bf2f(a8[e]);
                const float kkr = kf * kkw; const float ss = __int_as_float(__builtin_amdgcn_readlane(ssw, bitrev3(e))); const float kk = kkr * rsqrt_fast(ss + 1e-12f);
                const float cw = pre + cl[e]; const float e1 = __expf(cw), e2 = __builtin_amdgcn_rcpf(e1), eC = expC * e2;
                const float kj = kf * (1.f + (al - 1.f) * kaw), kb = kk * al;
                *(LAS unsigned short*)(gb + WK_A + s * ST64 + lane * 2) = f2bf(-kk * ePrev); ePrev = e1;
                *(LAS unsigned short*)(gb + WK_R + s * ST64 + lane * 2) = f2bf(rf * e1);
                *(LAS unsigned short*)(gb + WK_B + s * ST64 + lane * 2) = f2bf(kb * e2);
                *(LAS unsigned short*)(gb + WK_K + s * ST64 + lane * 2) = f2bf(kj * e2);
                bh8[e] = kb * eC; kh8[e] = kj * eC;
                bn[e] = rf * kj * rkw;
            }
            { const float bsw = wave_sum8(bn, lane);
              if (lane < 8) { const int sg = seg * 2048 + ch * 32 + 8 * wq + (((lane & 1) << 2) | (lane & 2) | ((lane >> 2) & 1)), t = dir ? Tseq - 1 - sg : sg; bon[(seqbase + t) * 32] = bsw; } }
            { u32x4 w; w.x = cvt_pk_bf16(bh8[0], bh8[1]); w.y = cvt_pk_bf16(bh8[2], bh8[3]); w.z = cvt_pk_bf16(bh8[4], bh8[5]); w.w = cvt_pk_bf16(bh8[6], bh8[7]); *(LAS u32x4*)(gb + WK_BH + lane * ST32 + 16 * wq) = w;
              w.x = cvt_pk_bf16(kh8[0], kh8[1]); w.y = cvt_pk_bf16(kh8[2], kh8[3]); w.z = cvt_pk_bf16(kh8[4], kh8[5]); w.w = cvt_pk_bf16(kh8[6], kh8[7]); *(LAS u32x4*)(gb + WK_KH + lane * ST32 + 16 * wq) = w;
              w.x = (unsigned)v8[0] | ((unsigned)v8[1] << 16); w.y = (unsigned)v8[2] | ((unsigned)v8[3] << 16); w.z = (unsigned)v8[4] | ((unsigned)v8[5] << 16); w.w = (unsigned)v8[6] | ((unsigned)v8[7] << 16);
              *(LAS u32x4*)(gb + WK_VT + lane * ST32 + 16 * wq) = w; }
            if (wq == 0) WC[lane] = expC;
            if (ch + 2 < 64) WK_LOAD(ch + 2);
            __syncthreads();
            {
                const int mt = wq >> 1, nt = wq & 1;
                f32x4 ab = zero4, ak = zero4, rb = zero4, rk = zero4, abT = zero4;
                if (mt >= nt) {
                    const int arow = 16 * mt + l15, brow = 16 * nt + l15;
#pragma unroll
                    for (int ks = 0; ks < 2; ++ks) {
                        const bf16x8 af = frag_nat(gb + WK_A + arow * ST64 + 64 * ks + 16 * g), rf = frag_nat(gb + WK_R + arow * ST64 + 64 * ks + 16 * g);
                        const bf16x8 bf_ = frag_nat(gb + WK_B + brow * ST64 + 64 * ks + 16 * g), kf_ = frag_nat(gb + WK_K + brow * ST64 + 64 * ks + 16 * g);
                        ab = MFMA16(af, bf_, ab); ak = MFMA16(af, kf_, ak); rb = MFMA16(rf, bf_, rb); rk = MFMA16(rf, kf_, rk);
                        if (mt == nt) abT = MFMA16(bf_, af, abT);
                    }
                }
#pragma unroll
                for (int e = 0; e < 4; ++e) { const int s = 16 * mt + 4 * g + e, i = 16 * nt + l15; const bool lo = i < s, le = i <= s;
                    if (wq == 2) *(LAS unsigned short*)(gb + WK_A10 + (s - 16) * 32 + i * 2) = f2bf(ab[e]);
                    *(LAS unsigned short*)(gb + WK_AAK + s * ST32 + i * 2) = f2bf(lo ? ak[e] : 0.f);
                    *(LAS unsigned short*)(gb + WK_ARB + s * ST32 + i * 2) = f2bf(le ? rb[e] : 0.f);
                    *(LAS unsigned short*)(gb + WK_ARK + s * ST32 + i * 2) = f2bf(le ? rk[e] : 0.f); }
                if (mt == nt) {
                    f32x4 X, XT, PT;
#pragma unroll
                    for (int e = 0; e < 4; ++e) { const int rr = 4 * g + e; X[e] = l15 < rr ? ab[e] : 0.f; XT[e] = rr < l15 ? abT[e] : 0.f; PT[e] = XT[e] + (rr == l15 ? 1.f : 0.f); }
                    const bf16x8 xa = pack_acc(X, zero4), xt = pack_acc(XT, zero4);
                    const f32x4 X2 = MFMA16(xt, xa, zero4), X2T = MFMA16(xa, xt, zero4);
                    const bf16x8 x2 = pack_acc(X2, zero4), x2t = pack_acc(X2T, zero4);
                    PT = MFMA16(x2, pack_acc(PT, zero4), PT);
                    const f32x4 X4 = MFMA16(x2t, x2, zero4), X4T = MFMA16(x2, x2t, zero4);
                    const bf16x8 x4 = pack_acc(X4, zero4), x4t = pack_acc(X4T, zero4);
                    PT = MFMA16(x4, pack_acc(PT, zero4), PT);
                    const f32x4 X8 = MFMA16(x4t, x4, zero4);
                    PT = MFMA16(pack_acc(X8, zero4), pack_acc(PT, zero4), PT);
                    u32x2 w; w.x = cvt_pk_bf16(PT[0], PT[1]); w.y = cvt_pk_bf16(PT[2], PT[3]);
                    *(LAS u32x2*)(gb + WK_TT + (16 * mt + l15) * ST32 + (16 * mt + 4 * g) * 2) = w;
                }
            }
            __syncthreads();
            const bf16x8 vfr = frag_nat(gb + WK_VT + (16 * wq + l15) * ST32 + 16 * g);
            bf16x8 t00f, t11f, a10f;
            { const s16x4 q0 = *(const LAS s16x4*)(gb + WK_TT + l15 * ST32 + 8 * g), q1 = *(const LAS s16x4*)(gb + WK_TT + (16 + l15) * ST32 + (16 + 4 * g) * 2), q2 = *(const LAS s16x4*)(gb + WK_A10 + l15 * 32 + 8 * g);
              t00f = (bf16x8){q0[0], q0[1], q0[2], q0[3], 0, 0, 0, 0}; t11f = (bf16x8){q1[0], q1[1], q1[2], q1[3], 0, 0, 0, 0}; a10f = (bf16x8){q2[0], q2[1], q2[2], q2[3], 0, 0, 0, 0}; }
            if (MODE == 0) {
                bf16x8 sf[2]; sf[0] = pack_acc(st[0], st[1]); sf[1] = pack_acc(st[2], st[3]);
                f32x4 z[2], u[2], y[2];
#pragma unroll
                for (int mt = 0; mt < 2; ++mt) { const int row = 16 * mt + l15;
                    z[mt] = MFMA16(frag_perm(gb + WK_A + row * ST64 + 8 * g), sf[0], zero4); z[mt] = MFMA16(frag_perm(gb + WK_A + row * ST64 + 64 + 8 * g), sf[1], z[mt]);
                    z[mt] = MFMA16(frag_nat(gb + WK_AAK + row * ST32 + 16 * g), vfr, z[mt]); }
                u[0] = MFMA16(t00f, pack_acc(z[0], zero4), zero4);
                z[1] = MFMA16(a10f, pack_acc(u[0], zero4), z[1]);
                u[1] = MFMA16(t11f, pack_acc(z[1], zero4), zero4);
                const bf16x8 uf = pack_acc(u[0], u[1]);
#pragma unroll
                for (int mt = 0; mt < 2; ++mt) { const int row = 16 * mt + l15;
                    y[mt] = MFMA16(frag_perm(gb + WK_R + row * ST64 + 8 * g), sf[0], zero4); y[mt] = MFMA16(frag_perm(gb + WK_R + row * ST64 + 64 + 8 * g), sf[1], y[mt]);
                    y[mt] = MFMA16(frag_perm(gb + WK_ARB + row * ST32 + 8 * g), uf, y[mt]); y[mt] = MFMA16(frag_nat(gb + WK_ARK + row * ST32 + 16 * g), vfr, y[mt]); }
#pragma unroll
                for (int m = 0; m < 4; ++m) { const int crow = 16 * m + l15; const f32x4 wc4 = *(const LAS f32x4*)(WC + 16 * m + 4 * g);
                    st[m] = st[m] * wc4; st[m] = MFMA16(frag_perm(gb + WK_BH + crow * ST32 + 8 * g), uf, st[m]); st[m] = MFMA16(frag_nat(gb + WK_KH + crow * ST32 + 16 * g), vfr, st[m]); }
#pragma unroll
                for (int mt = 0; mt < 2; ++mt)
#pragma unroll
                    for (int e = 0; e < 4; ++e) { const int sg = seg * 2048 + ch * 32 + 16 * mt + 4 * g + e, t = dir ? Tseq - 1 - sg : sg;
                        yo[(seqbase + t) * D + hc + 16 * wq + l15] = f2bf(y[mt][e]); }
            } else {
                bf16x8 sf[2], sfi[2]; sf[0] = pack_acc(st[0], st[1]); sf[1] = pack_acc(st[2], st[3]); sfi[0] = pack_acc(sid[0], sid[1]); sfi[1] = pack_acc(sid[2], sid[3]);
                f32x4 z[2], zi[2], u[2], ui[2];
#pragma unroll
                for (int mt = 0; mt < 2; ++mt) { const int row = 16 * mt + l15; const bf16x8 a0 = frag_perm(gb + WK_A + row * ST64 + 8 * g), a1 = frag_perm(gb + WK_A + row * ST64 + 64 + 8 * g);
                    z[mt] = MFMA16(a0, sf[0], zero4); z[mt] = MFMA16(a1, sf[1], z[mt]); z[mt] = MFMA16(frag_nat(gb + WK_AAK + row * ST32 + 16 * g), vfr, z[mt]);
                    zi[mt] = MFMA16(a0, sfi[0], zero4); zi[mt] = MFMA16(a1, sfi[1], zi[mt]); }
                u[0] = MFMA16(t00f, pack_acc(z[0], zero4), zero4); ui[0] = MFMA16(t00f, pack_acc(zi[0], zero4), zero4);
                z[1] = MFMA16(a10f, pack_acc(u[0], zero4), z[1]); zi[1] = MFMA16(a10f, pack_acc(ui[0], zero4), zi[1]);
                u[1] = MFMA16(t11f, pack_acc(z[1], zero4), zero4); ui[1] = MFMA16(t11f, pack_acc(zi[1], zero4), zero4);
                const bf16x8 uf = pack_acc(u[0], u[1]), ufi = pack_acc(ui[0], ui[1]);
                __builtin_amdgcn_sched_barrier(0);
                bf16* mb = MB + ((size_t)task * 64 + ch) * 2048;
#pragma unroll
                for (int mt = 0; mt < 2; ++mt) { const int row = 16 * mt + l15; const bf16x8 r0 = frag_perm(gb + WK_R + row * ST64 + 8 * g), r1 = frag_perm(gb + WK_R + row * ST64 + 64 + 8 * g), rbf = frag_perm(gb + WK_ARB + row * ST32 + 8 * g);
                    f32x4 y = MFMA16(r0, sf[0], zero4); y = MFMA16(r1, sf[1], y); y = MFMA16(rbf, uf, y); y = MFMA16(frag_nat(gb + WK_ARK + row * ST32 + 16 * g), vfr, y);
                    f32x4 yi = MFMA16(r0, sfi[0], zero4); yi = MFMA16(r1, sfi[1], yi); yi = MFMA16(rbf, ufi, yi);
#pragma unroll
                    for (int e = 0; e < 4; ++e) { const int s = 16 * mt + 4 * g + e, sg = seg * 2048 + ch * 32 + s, t = dir ? Tseq - 1 - sg : sg;
                        yo[(seqbase + t) * D + hc + 16 * wq + l15] = f2bf(y[e]); mb[s * 64 + 16 * wq + l15] = f2bf(yi[e]); } }
                __builtin_amdgcn_sched_barrier(0);
#pragma unroll
                for (int m = 0; m < 4; ++m) { const int crow = 16 * m + l15; const f32x4 wc4 = *(const LAS f32x4*)(WC + 16 * m + 4 * g); const bf16x8 bhf = frag_perm(gb + WK_BH + crow * ST32 + 8 * g);
                    st[m] = st[m] * wc4; st[m] = MFMA16(bhf, uf, st[m]); st[m] = MFMA16(frag_nat(gb + WK_KH + crow * ST32 + 16 * g), vfr, st[m]);
                    sid[m] = sid[m] * wc4; sid[m] = MFMA16(bhf, ufi, sid[m]); }
            }
        }
#undef WK_LOAD
        if (MODE == 1 && seg < 7) {
            float* Pi = PT + (size_t)task * 8192; float* Th = Pi + 4096;
#pragma unroll
            for (int m = 0; m < 4; ++m)
#pragma unroll
                for (int e = 0; e < 4; ++e) { const int o = (16 * m + 4 * g + e) * 64 + 16 * wq + l15; Pi[o] = sid[m][e]; Th[o] = st[m][e]; }
        }
    }
}

DI void phase_wkv_fix(const Frame& F, const float* PT, const bf16* MB, bf16* Y) {
    const int lane = F.lane, l15 = lane & 15, g = lane >> 4, wq = F.wave & 3, grp = F.wave >> 2;
    const int Tseq = S;
    const f32x4 zero4 = (f32x4){0.f, 0.f, 0.f, 0.f};
    for (int task = F.vcu * 2 + grp; task < 512; task += F.G * 2) {
        const int chain = task >> 3, head = chain >> 1, dir = chain & 1, seg = task & 7;
        if (seg == 0) continue;
        f32x4 st[4];
#pragma unroll
        for (int m = 0; m < 4; ++m) st[m] = zero4;
        for (int j = 0; j < seg; ++j) {
            const float* Pi = PT + (size_t)((task & ~7) + j) * 8192; const float* Th = Pi + 4096;
            bf16x8 sf[2]; sf[0] = pack_acc(st[0], st[1]); sf[1] = pack_acc(st[2], st[3]);
#pragma unroll
            for (int m = 0; m < 4; ++m) { f32x4 nw;
#pragma unroll
                for (int e = 0; e < 4; ++e) nw[e] = Th[(16 * m + 4 * g + e) * 64 + 16 * wq + l15];
#pragma unroll
                for (int ks = 0; ks < 2; ++ks) { const float* pr = Pi + (16 * m + l15) * 64 + 32 * ks + 4 * g; const f32x4 lo = *(const f32x4*)pr, hi = *(const f32x4*)(pr + 16);
                    nw = MFMA16(pack_acc(lo, hi), sf[ks], nw); }
                st[m] = nw; }
        }
        bf16x8 sf[2]; sf[0] = pack_acc(st[0], st[1]); sf[1] = pack_acc(st[2], st[3]);
        bf16* yo = Y + (size_t)dir * SLOT_ELEMS; const int hc = head * 64;
        u32x2 mlo[2][2][2], mhi[2][2][2]; unsigned short yv[2][2][4];
#define FIX_LOAD(c_) do { _Pragma("unroll") for (int q = 0; q < 2; ++q) { const bf16* mb = MB + ((size_t)task * 64 + (c_) + q) * 2048; \
            _Pragma("unroll") for (int mt = 0; mt < 2; ++mt) { const bf16* mr = mb + (16 * mt + l15) * 64 + 4 * g; \
                _Pragma("unroll") for (int ks = 0; ks < 2; ++ks) { mlo[q][mt][ks] = *(const u32x2*)(mr + 32 * ks); mhi[q][mt][ks] = *(const u32x2*)(mr + 32 * ks + 16); } \
                _Pragma("unroll") for (int e = 0; e < 4; ++e) { const int sg = seg * 2048 + ((c_) + q) * 32 + 16 * mt + 4 * g + e, t = dir ? Tseq - 1 - sg : sg; yv[q][mt][e] = yo[(size_t)t * D + hc + 16 * wq + l15]; } } } } while (0)
        FIX_LOAD(0);
#pragma unroll 1
        for (int c2 = 0; c2 < 64; c2 += 2) {
            f32x4 acc[2][2]; float yf[2][2][4];
#pragma unroll
            for (int q = 0; q < 2; ++q)
#pragma unroll
                for (int mt = 0; mt < 2; ++mt) { acc[q][mt] = zero4;
#pragma unroll
                    for (int ks = 0; ks < 2; ++ks) { const u32x4 w = (u32x4){mlo[q][mt][ks].x, mlo[q][mt][ks].y, mhi[q][mt][ks].x, mhi[q][mt][ks].y}; acc[q][mt] = MFMA16(__builtin_bit_cast(bf16x8, w), sf[ks], acc[q][mt]); }
#pragma unroll
                    for (int e = 0; e < 4; ++e) yf[q][mt][e] = bf2f(yv[q][mt][e]); }
            if (c2 + 2 < 64) FIX_LOAD(c2 + 2);
#pragma unroll
            for (int q = 0; q < 2; ++q)
#pragma unroll
                for (int mt = 0; mt < 2; ++mt)
#pragma unroll
                    for (int e = 0; e < 4; ++e) { const int sg = seg * 2048 + (c2 + q) * 32 + 16 * mt + 4 * g + e, t = dir ? Tseq - 1 - sg : sg; yo[(size_t)t * D + hc + 16 * wq + l15] = f2bf(yf[q][mt][e] + acc[q][mt][e]); }
        }
#undef FIX_LOAD
    }
}
DI unsigned v_off(unsigned row, unsigned ch) { return 256u * row + 16u * (ch ^ (((row & 3u) << 2) | ((row >> 2) & 3u))); }
DI bf16x8 tr_read2(unsigned a0, unsigned a1) {
    s16x4 lo, hi; asm volatile("ds_read_b64_tr_b16 %0, %2\n\tds_read_b64_tr_b16 %1, %3\n\ts_waitcnt lgkmcnt(0)" : "=&v"(lo), "=&v"(hi) : "v"(a0), "v"(a1) : "memory");
    return (bf16x8){lo[0], lo[1], lo[2], lo[3], hi[0], hi[1], hi[2], hi[3]};
}
constexpr int ATT_RING = 65536;
DI void tr_read4_nw(unsigned alo, unsigned ahi, s16x4 (&lo)[2], s16x4 (&hi)[2]) {
    asm volatile("ds_read_b64_tr_b16 %0, %4\n\tds_read_b64_tr_b16 %2, %5\n\tds_read_b64_tr_b16 %1, %4 offset:8192\n\tds_read_b64_tr_b16 %3, %5 offset:8192"
                 : "=&v"(lo[0]), "=&v"(lo[1]), "=&v"(hi[0]), "=&v"(hi[1]) : "v"(alo), "v"(ahi) : "memory");
}
DI void tr_wait12(s16x4 (&a)[2], s16x4 (&b)[2], s16x4 (&c)[2], s16x4 (&d)[2], s16x4 (&e)[2], s16x4 (&f)[2]) {
    asm volatile("s_waitcnt lgkmcnt(0)" : "+v"(a[0]), "+v"(a[1]), "+v"(b[0]), "+v"(b[1]), "+v"(c[0]), "+v"(c[1]), "+v"(d[0]), "+v"(d[1]), "+v"(e[0]), "+v"(e[1]), "+v"(f[0]), "+v"(f[1]) :: "memory");
}
struct AU { int gi, dil, NT, cls, up, run; size_t seqbase; };
DI AU au_decode(int k, int part, int Tseq) {
    AU a; a.gi = k >> 3; const int idx = 8 * part + (k & 7); a.dil = a.gi == 0 ? 1 : (a.gi == 1 ? 4 : 16); const int L = Tseq / a.dil; a.NT = L >> 6; const int upr = L >> 7;
    a.run = idx / upr; a.up = idx - a.run * upr; const int seq = a.run / a.dil; a.cls = a.run - seq * a.dil; a.seqbase = (size_t)seq * Tseq; return a;
}
DI void att_tiles_load(const bf16* QKV, const AU& a, int head, int t0, int tid, u32x4 (&kr)[4], u32x4 (&vr)[4]) {
    const int kcol = a.gi * 6144 + 2048 + head * 128;
#pragma unroll
    for (int i = 0; i < 4; ++i) { const int id = tid + 512 * i, tl = id >> 10, rem = id & 1023, r = rem >> 4, ch = rem & 15; int t = t0 + tl; t = t < 0 ? 0 : (t >= a.NT ? a.NT - 1 : t);
        const bf16* p = QKV + (a.seqbase + (size_t)(64 * t + r) * a.dil + a.cls) * NQKV + kcol + 8 * ch; kr[i] = *(const u32x4*)p; vr[i] = *(const u32x4*)(p + 2048); }
}
DI void att_tiles_store(LAS unsigned char* ring, int t0, int tid, const u32x4 (&kr)[4], const u32x4 (&vr)[4]) {
#pragma unroll
    for (int i = 0; i < 4; ++i) { const int id = tid + 512 * i, tl = id >> 10, rem = id & 1023, r = rem >> 4, ch = rem & 15; const unsigned o = v_off((unsigned)(((t0 + tl) & 3) * 64 + r), ch);
        *(LAS u32x4*)(ring + o) = kr[i]; *(LAS u32x4*)(ring + ATT_RING + o) = vr[i]; }
}
DI void phase_attn(const Frame& F, const bf16* QKV, int Tseq, const float* biastab, bf16* OG, float* LSE, const int gsel) {
    const int lane = F.lane, l15 = lane & 15, g = lane >> 4, blk = F.wave >> 2, wq = F.wave & 3, tid = F.tid;
    constexpr float LOG2E = 1.4426950408889634f, SCALE = 0.08838834764831845f * LOG2E;
    LAS unsigned char* ring = F.lds;
    const unsigned vbase = (unsigned)(uintptr_t)(F.ldsg + ATT_RING);
    const int qi = 16 * wq + l15;
    for (int vw = F.vcu; vw < 256; vw += F.G) {
        const int head = vw & 15, part = vw >> 4;
        unsigned biasp[6][2][2]; int gi_cur = -1;
        u32x4 kb[4], vb[4];
        { const AU a0 = au_decode(8 * gsel, part, Tseq); att_tiles_load(QKV, a0, head, 2 * a0.up - 1, tid, kb, vb); }
        int pgi = -1, prun = -1, pup = -9;
#pragma unroll 1
        for (int kk = 0; kk < 8; ++kk) { int gs_ = gsel; asm volatile("" : "+s"(gs_)); const int k = 8 * gs_ + kk;
            const AU a = au_decode(k, part, Tseq);
            if (a.gi != gi_cur) { gi_cur = a.gi; const float* bt = biastab + (a.gi * 16 + head) * 129;
#pragma unroll
                for (int ks = 0; ks < 6; ++ks)
#pragma unroll
                    for (int tau = 0; tau < 2; ++tau)
#pragma unroll
                        for (int e2 = 0; e2 < 2; ++e2) { int o0 = 32 * ks + 8 * g + 4 * tau + 2 * e2 - qi, o1 = o0 + 1; o0 = o0 < 0 ? 0 : (o0 > 128 ? 128 : o0); o1 = o1 < 0 ? 0 : (o1 > 128 ? 128 : o1);
                            biasp[ks][tau][e2] = cvt_pk_bf16(bt[o0] * LOG2E, bt[o1] * LOG2E); } }
            const bool cont = (a.gi == pgi) && (a.run == prun) && (a.up == pup + 1);
            pgi = a.gi; prun = a.run; pup = a.up;
            const int n = 2 * a.up + blk;
            const size_t tq = a.seqbase + (size_t)(64 * n + qi) * a.dil + a.cls; const int qcol = a.gi * 6144 + head * 128;
            bf16x8 qf[4];
#pragma unroll
            for (int s = 0; s < 4; ++s) qf[s] = *(const bf16x8*)(QKV + tq * NQKV + qcol + 32 * s + 8 * g);
            __syncthreads();
            if (!cont) { att_tiles_store(ring, 2 * a.up - 1, tid, kb, vb); att_tiles_load(QKV, a, head, 2 * a.up + 1, tid, kb, vb); }
            att_tiles_store(ring, 2 * a.up + 1, tid, kb, vb);
            __syncthreads();
            f32x4 sc[6][2];
#pragma unroll
            for (int ks = 0; ks < 6; ++ks) {
                const unsigned rbase = (unsigned)(((n - 1 + (ks >> 1)) & 3) * 64 + 32 * (ks & 1));
#pragma unroll
                for (int tau = 0; tau < 2; ++tau) {
                    const unsigned row = rbase + 8 * (l15 >> 2) + 4 * tau + (l15 & 3);
                    f32x4 acc = (f32x4){0.f, 0.f, 0.f, 0.f};
#pragma unroll
                    for (int s = 0; s < 4; ++s) { const bf16x8 kf = *(const LAS bf16x8*)(ring + v_off(row, 4 * s + g)); acc = __builtin_amdgcn_mfma_f32_16x16x32_bf16(kf, qf[s], acc, 0, 0, 0); }
                    sc[ks][tau] = acc;
                }
                if (ks & 1) __builtin_amdgcn_sched_barrier(0);
            }
            const bool first = (n == 0), last = (n == a.NT - 1);
            float mx = -1e30f;
#pragma unroll
            for (int ks = 0; ks < 6; ++ks)
#pragma unroll
                for (int tau = 0; tau < 2; ++tau)
#pragma unroll
                    for (int e = 0; e < 4; ++e) { const int j = 32 * ks + 8 * g + 4 * tau + e;
                        const bool ok = ks < 2 ? (j >= qi && !first) : (ks >= 4 ? (j - 128 <= qi && !last) : true);
                        const unsigned bw = biasp[ks][tau][e >> 1]; const float bv = (e & 1) ? bfhi(bw) : bflo(bw);
                        const float lg = ok ? sc[ks][tau][e] * SCALE + bv : -1e30f; sc[ks][tau][e] = lg; mx = fmaxf(mx, lg); }
            mx = rows_max(mx);
            float sum = 0.f; bf16x8 pf[6];
#pragma unroll
            for (int ks = 0; ks < 6; ++ks) { float p[8];
#pragma unroll
                for (int tau = 0; tau < 2; ++tau)
#pragma unroll
                    for (int e = 0; e < 4; ++e) { const float pe = __builtin_amdgcn_exp2f(sc[ks][tau][e] - mx); p[4 * tau + e] = pe; sum += pe; }
                u32x4 w; w.x = cvt_pk_bf16(p[0], p[1]); w.y = cvt_pk_bf16(p[2], p[3]); w.z = cvt_pk_bf16(p[4], p[5]); w.w = cvt_pk_bf16(p[6], p[7]); pf[ks] = __builtin_bit_cast(bf16x8, w); }
            sum = rows_sum(sum);
            const float inv = __builtin_amdgcn_rcpf(sum);
            if (kk + 1 < 8) { const AU nx = au_decode(k + 1, part, Tseq); const bool ncont = (nx.gi == a.gi) && (nx.run == a.run) && (nx.up == a.up + 1);
                att_tiles_load(QKV, nx, head, ncont ? 2 * nx.up + 1 : 2 * nx.up - 1, tid, kb, vb); }
            const unsigned q4 = (unsigned)l15 >> 2, pp = (unsigned)lane & 3u;
            const unsigned s0 = (unsigned)((n - 1) & 3) * 16384u, s1 = (unsigned)(n & 3) * 16384u, s2 = (unsigned)((n + 1) & 3) * 16384u;
            bf16* orow = OG + (size_t)a.gi * SLOT_ELEMS + tq * D + head * 128 + 4 * g;
#pragma unroll
            for (int c = 0; c < 8; ++c) {
                const unsigned r0 = 8u * g + q4, ch = 2u * c + (pp >> 1);
                const unsigned alo = vbase + v_off(r0, ch) + 8u * (pp & 1u), ahi = vbase + v_off(r0 + 4u, ch) + 8u * (pp & 1u);
                s16x4 l0[2], h0[2], l1[2], h1[2], l2[2], h2[2];
                tr_read4_nw(alo + s0, ahi + s0, l0, h0); tr_read4_nw(alo + s1, ahi + s1, l1, h1); tr_read4_nw(alo + s2, ahi + s2, l2, h2);
                tr_wait12(l0, h0, l1, h1, l2, h2);
                f32x4 oa = (f32x4){0.f, 0.f, 0.f, 0.f};
#define ATT_PV(L_, H_, KS_) oa = __builtin_amdgcn_mfma_f32_16x16x32_bf16((bf16x8){L_[0], L_[1], L_[2], L_[3], H_[0], H_[1], H_[2], H_[3]}, pf[KS_], oa, 0, 0, 0)
                ATT_PV(l0[0], h0[0], 0); ATT_PV(l0[1], h0[1], 1); ATT_PV(l1[0], h1[0], 2); ATT_PV(l1[1], h1[1], 3); ATT_PV(l2[0], h2[0], 4); ATT_PV(l2[1], h2[1], 5);
#undef ATT_PV
                u32x2 w; w.x = cvt_pk_bf16(oa[0] * inv, oa[1] * inv); w.y = cvt_pk_bf16(oa[2] * inv, oa[3] * inv);
                *(u32x2*)(orow + 16 * c) = w; }
            if (g == 0) LSE[(size_t)a.gi * S * 16 + tq * 16 + head] = (mx + __builtin_amdgcn_logf(sum)) * 0.6931471805599453f;
        }
    }
}
DI void phase_attn_combine(const Frame& F, const bf16* OG, const float* LSE, unsigned char* out, float* asc) {
    for (int row = F.gw; row < S; row += F.NGW) {
        float o[4][8]; float mx = 0.f;
#pragma unroll
        for (int jj = 0; jj < 4; ++jj) {
            const int c0 = 512 * jj + 8 * F.lane, head = c0 >> 7; const size_t e0 = (size_t)row * D + c0;
            const float l0 = LSE[(size_t)row * 16 + head], l1 = LSE[(size_t)S * 16 + (size_t)row * 16 + head], l2 = LSE[(size_t)2 * S * 16 + (size_t)row * 16 + head];
            const float m = fmaxf(l0, fmaxf(l1, l2)); float w0 = __expf(l0 - m), w1 = __expf(l1 - m), w2 = __expf(l2 - m); const float inv = 1.f / (w0 + w1 + w2); w0 *= inv; w1 *= inv; w2 *= inv;
            float a[8], b[8], c[8];
            unpack8(*(const u32x4*)(OG + e0), a); unpack8(*(const u32x4*)(OG + SLOT_ELEMS + e0), b); unpack8(*(const u32x4*)(OG + 2 * SLOT_ELEMS + e0), c);
#pragma unroll
            for (int e = 0; e < 8; ++e) { o[jj][e] = w0 * a[e] + w1 * b[e] + w2 * c[e]; mx = fmaxf(mx, fabsf(o[jj][e])); }
        }
        mx = wave_max(mx); const float qi = mx > 0.f ? 127.f / mx : 0.f;
#pragma unroll
        for (int jj = 0; jj < 4; ++jj) { u32x2 w; w.x = pack4_i8(o[jj][0] * qi, o[jj][1] * qi, o[jj][2] * qi, o[jj][3] * qi); w.y = pack4_i8(o[jj][4] * qi, o[jj][5] * qi, o[jj][6] * qi, o[jj][7] * qi);
            *(u32x2*)(out + (size_t)row * D + 512 * jj + 8 * F.lane) = w; }
        if (F.lane == 0) asc[row] = mx * (1.f / 127.f);
    }
}
constexpr int QPL = 16;
#ifndef PG_ALIGN
#define PG_ALIGN true
#endif
#ifndef PG_SP2
#define PG_SP2 true
#endif
__global__ void __launch_bounds__(NWAVES * 64, 2) fwd_kernel(Args a_unused) {
    extern __shared__ __attribute__((aligned(16))) unsigned char lds[];
#define MKFRAME() Frame F; { int tid_; asm volatile("v_mbcnt_lo_u32_b32 %0, -1, 0\n\tv_mbcnt_hi_u32_b32 %0, -1, %0" : "=v"(tid_)); tid_ += wave_s * 64;     int bx_ = blockIdx.x, g_ = gridDim.x; asm volatile("" : "+s"(bx_), "+s"(g_)); \
        F.lds = (LAS unsigned char*)lds; F.ldsg = lds; F.tid = tid_; F.lane = tid_ & 63; F.wave = __builtin_amdgcn_readfirstlane(tid_ >> 6); \
        F.G = g_; F.vcu = (g_ % 8 == 0) ? (bx_ % 8) * (g_ / 8) + bx_ / 8 : bx_; F.gw = F.vcu * NWAVES + F.wave; F.NGW = g_ * NWAVES; }
    const int wave_s = __builtin_amdgcn_readfirstlane((int)threadIdx.x >> 6);
    volatile LAS unsigned* MISC = (volatile LAS unsigned*)((LAS unsigned char*)lds + MISC_OFF);
    for (int u = threadIdx.x; u < (LDS_BYTES - LDSCTL_OFF) / 4; u += NWAVES * 64) ((LAS unsigned*)((LAS unsigned char*)lds + LDSCTL_OFF))[u] = 0u;
    __syncthreads();
    int slab_lo, slab_hi, ph_lo, ph_hi, use_bar, do_pro;
    XcdBarrier bar;
    { ArgsP ap = args_ptr(); slab_lo = ap->slab_lo; slab_hi = ap->slab_hi; ph_lo = ap->ph_lo; ph_hi = ap->ph_hi; use_bar = ap->use_bar; do_pro = ap->do_pro;
      bar.bar = (unsigned*)(ap->ws + WS_CTL) + CW_BAR; bar.x = 0; bar.st = nullptr; bar.w = wave_s;
      if (use_bar) { bar = xcd_barrier_post((unsigned*)(ap->ws + WS_CTL) + CW_BAR, MISC + 8); bar.w = wave_s; } }
#define SEAM() do { if (use_bar) xcd_barrier(bar); } while (0)
#define SLOT(i) ((bf16*)(ws + WS_SLOT) + (size_t)(i) * SLOT_ELEMS)
#define LDA() MKFRAME(); ArgsP ap = args_ptr(); unsigned char* ws = ap->ws; (void)ws; const int c_ord = (int)blockIdx.x; (void)c_ord

    if (do_pro & 1) { MKFRAME(); p0_scales(F); SEAM(); }
    if (do_pro & 2) { MKFRAME(); p0_prologue(F); SEAM(); }

    for (int slab = slab_lo; slab < slab_hi; ++slab) {
        const int nseq = slab < 2 ? 8 : 1, Tseq = S / nseq;
#pragma unroll 1
        for (int layer = 0; layer < 2; ++layer) {
            const int step0 = (slab * 2 + layer) * QPL;
#if MK_ONE_LAUNCH
#define RUN(q) true
#else
#define RUN(q) (ph_lo <= step0 + (q) && step0 + (q) < ph_hi)
#endif
#define XIN ((slab < 2 ? ap->in[0] : ap->in[1]) + (size_t)(slab & 1) * S * D)
#define XOUT (ap->out + (size_t)slab * S * D)
#define XBF ((bf16*)XOUT + (size_t)S * D)
#define GAINS (ap->in[4] + (size_t)layer * 4 * D)
#define PIN ((slab < 2 ? ap->in[2] : ap->in[3]) + ((size_t)layer * 2 * S + (size_t)(slab & 1) * S) * PLE)
            if (layer == 0) {
                if (RUN(0)) { LDA(); phase_mix(F, XIN, Tseq, GAINS, ap->in[6], SLOT(0)); SEAM(); }
                if (RUN(1)) { LDA();
                    pg8::Gemm g{SLOT(0), (const bf16*)(ws + WS_WB0), D}; pg8::MultiOrder<pg8::TabL0B> O{F.G, c_ord};
                    pg8::EpiL0B E{SLOT(6), (bf16*)(ws + WS_HL)};
                    pg8::gemm_phase<pg8::EpiL0B, pg8::MultiOrder<pg8::TabL0B>, PG_ALIGN, PG_SP2>(F.lds, g, O, E, F.tid); SEAM(); }
                if (RUN(2)) { LDA();
                    pg8::Gemm g{(const bf16*)(ws + WS_HL), (const bf16*)(ws + WS_WL2), 256}; pg8::MultiOrder<pg8::TabL0C> O{F.G, c_ord};
                    pg8::EpiL0C E{SLOT(0), ap->in[8], ap->in[11]};
                    pg8::gemm_phase<pg8::EpiL0C, pg8::MultiOrder<pg8::TabL0C>, PG_ALIGN, PG_SP2>(F.lds, g, O, E, F.tid); SEAM(); }
                if (RUN(3) && nseq == 1) { LDA(); phase_wkv<1>(F, nseq, SLOT(6), SLOT(7), SLOT(8), SLOT(0), ap->in[16], ap->in[17], ap->in[18], SLOT(9), (float*)(ws + WS_PT), SLOT(11), (float*)(ws + WS_PB)); SEAM(); }
                if (RUN(4)) { LDA(); if (nseq == 1) phase_wkv_fix(F, (const float*)(ws + WS_PT), SLOT(11), SLOT(9)); else phase_wkv<0>(F, nseq, SLOT(6), SLOT(7), SLOT(8), SLOT(0), ap->in[16], ap->in[17], ap->in[18], SLOT(9), (float*)(ws + WS_PT), nullptr, (float*)(ws + WS_PB)); SEAM(); }
                if (RUN(5)) { LDA(); phase_post(F, SLOT(9), SLOT(10), SLOT(8), SLOT(4), (const float*)(ws + WS_PB), ap->in[19], ap->in[20], (unsigned char*)SLOT(5), (float*)(ws + WS_ASC)); SEAM(); }
            } else {
                if (RUN(0)) { LDA(); phase_resnorm<false, false>(F, XBF, nullptr, nullptr, nullptr, GAINS, (unsigned char*)SLOT(0), (float*)(ws + WS_ASC), nullptr, nullptr); SEAM(); }
#pragma unroll 1
                for (int gi = 0; gi < 3; ++gi) {
                    if (RUN(1 + 2 * gi)) { LDA();
                        pg8::Gemm g{SLOT(0), (const bf16*)(ws + WS_WQKV) + (size_t)gi * 6144 * (D / 2), D / 2}; pg8::MultiOrder<pg8::TabOne<24>> O{F.G, c_ord};
                        pg8::EpiPlainI8 E{SLOT(1) + gi * 6144, NQKV, (const float*)(ws + WS_ASC), (const float*)(ws + WS_WSC) + WSC_QKV + gi * 6144};
                        pg8::gemm_phase<pg8::EpiPlainI8, pg8::MultiOrder<pg8::TabOne<24>>, PG_ALIGN, PG_SP2>(F.lds, g, O, E, F.tid); SEAM(); }
                    if (RUN(2 + 2 * gi)) { LDA(); phase_attn(F, SLOT(1), Tseq, (const float*)(ws + WS_BIAS), SLOT(10), (float*)(ws + WS_LSE), gi); SEAM(); }
                }
                if (RUN(7)) { LDA(); phase_attn_combine(F, SLOT(10), (const float*)(ws + WS_LSE), (unsigned char*)SLOT(0), (float*)(ws + WS_ASC)); SEAM(); }
                if (RUN(8)) { LDA();
                    pg8::Gemm g{SLOT(0), (const bf16*)(ws + WS_WO1), D / 2}; pg8::MultiOrder<pg8::TabOne<8>> O{F.G, c_ord};
                    pg8::EpiPlainI8 E{SLOT(1), D, (const float*)(ws + WS_ASC), (const float*)(ws + WS_WSC) + WSC_WO + D};
                    pg8::gemm_phase<pg8::EpiPlainI8, pg8::MultiOrder<pg8::TabOne<8>>, PG_ALIGN, PG_SP2>(F.lds, g, O, E, F.tid); SEAM(); }
            }
            const int sA = layer ? 0 : 5, sB = layer ? 1 : 0, sC = layer ? 2 : 1, sD = layer ? 3 : 2, sE = layer ? 6 : 5;
            if (RUN(9) && layer == 0) { LDA();
                pg8::Gemm g{SLOT(sA), (const bf16*)(ws + WS_WO0), D / 2}; pg8::MultiOrder<pg8::TabOne<8>> O{F.G, c_ord};
                pg8::EpiPlainI8 E{SLOT(sB), D, (const float*)(ws + WS_ASC), (const float*)(ws + WS_WSC) + WSC_WO};
                pg8::gemm_phase<pg8::EpiPlainI8, pg8::MultiOrder<pg8::TabOne<8>>, PG_ALIGN, PG_SP2>(F.lds, g, O, E, F.tid); SEAM(); }
            if (RUN(10)) { LDA(); if (layer == 0) phase_resnorm<true, true>(F, XIN, XBF, SLOT(sB), GAINS + D, GAINS + 2 * D, (unsigned char*)SLOT(sC), (float*)(ws + WS_ASC), PIN, (bf16*)(ws + WS_PB));
                else phase_resnorm<true, false>(F, XBF, XBF, SLOT(sB), GAINS + D, GAINS + 2 * D, (unsigned char*)SLOT(sC), (float*)(ws + WS_ASC), PIN, (bf16*)(ws + WS_PB)); SEAM(); }
            if (RUN(11)) { LDA();
                pg8::Gemm g{SLOT(sC), (const bf16*)(ws + WS_WGU) + (size_t)layer * FF * D, D / 2}; pg8::MultiOrder<pg8::TabOne<44>> O{F.G, c_ord};
                pg8::EpiSwiGLUI8 E{SLOT(sD), (const float*)(ws + WS_ASC), (const float*)(ws + WS_WSC) + WSC_GU + layer * 2 * FF};
                pg8::gemm_phase<pg8::EpiSwiGLUI8, pg8::MultiOrder<pg8::TabOne<44>>, PG_ALIGN, PG_SP2>(F.lds, g, O, E, F.tid); SEAM(); }
            if (RUN(14)) { LDA(); phase_quant_hidden(F, SLOT(sD), (unsigned char*)SLOT(10), (float*)(ws + WS_ASC)); SEAM(); }
            if (RUN(12)) { LDA();
                { pg8::Gemm g{SLOT(10), (const bf16*)(ws + WS_WDN) + (size_t)layer * D * FF, FF / 2}; pg8::MultiOrder<pg8::TabOne<8>> O{F.G, c_ord};
                  pg8::EpiPlainI8 E{SLOT(sB), D, (const float*)(ws + WS_ASC), (const float*)(ws + WS_WSC) + WSC_DN + (layer ? 0 : 2048)};
                  pg8::gemm_phase<pg8::EpiPlainI8, pg8::MultiOrder<pg8::TabOne<8>>, PG_ALIGN, PG_SP2>(F.lds, g, O, E, F.tid); }
                { int kple = PLE; asm volatile("" : "+s"(kple));
                  pg8::Gemm g{(const bf16*)(ws + WS_PB), (const bf16*)(ws + WS_WPP) + (size_t)layer * D * PLE, kple}; pg8::MultiOrder<pg8::TabOne<8>> O{F.G, c_ord};
                  pg8::EpiPlain E{SLOT(sE), D};
                  pg8::gemm_phase<pg8::EpiPlain, pg8::MultiOrder<pg8::TabOne<8>>, PG_ALIGN, PG_SP2>(F.lds, g, O, E, F.tid); }
                SEAM(); }
            if (RUN(13)) { LDA(); phase_resnorm<true, false>(F, XBF, layer ? SLOT(7) : XBF, SLOT(sB), GAINS + 3 * D, ap->in[26] + (size_t)layer * D, (unsigned char*)SLOT(sC), (float*)(ws + WS_ASC), nullptr, nullptr); SEAM(); }
            if (RUN(15)) { LDA();
                pg8::Gemm g{SLOT(sC), (const bf16*)(ws + WS_WPG) + (size_t)layer * D * D / 2, D / 2}; pg8::MultiOrder<pg8::TabOne<8>> O{F.G, c_ord};
                pg8::EpiPleGateI8 E{layer ? SLOT(7) : XBF, XBF, layer ? XOUT : nullptr, SLOT(sE), (const float*)(ws + WS_ASC), (const float*)(ws + WS_WSC) + WSC_PG + layer * D};
                pg8::gemm_phase<pg8::EpiPleGateI8, pg8::MultiOrder<pg8::TabOne<8>>, PG_ALIGN, PG_SP2>(F.lds, g, O, E, F.tid); SEAM(); }
#undef RUN
        }
    }
}

extern "C" void kernel_launch(void* const* d_in, const int* in_sizes, int n_in, void* d_out, int out_size, void* d_ws, size_t ws_size, hipStream_t stream) {
    static int grid = 0;
    if (grid == 0) {
        if (n_in != 29 || ws_size < WS_END) { fprintf(stderr, "kernel_launch: unexpected inputs (n_in %d, ws %zu)\n", n_in, ws_size); grid = -1; return; }
        int dev = 0, cus = 0, per_cu = 0;
        if (hipGetDevice(&dev) != hipSuccess || hipDeviceGetAttribute(&cus, hipDeviceAttributeMultiprocessorCount, dev) != hipSuccess) { grid = -1; return; }
        if (hipFuncSetAttribute((const void*)fwd_kernel, hipFuncAttributeMaxDynamicSharedMemorySize, LDS_BYTES) != hipSuccess) { fprintf(stderr, "kernel_launch: hipFuncSetAttribute failed\n"); grid = -1; return; }
        if (hipOccupancyMaxActiveBlocksPerMultiprocessor(&per_cu, (const void*)fwd_kernel, NWAVES * 64, LDS_BYTES) != hipSuccess || per_cu < 1) fprintf(stderr, "kernel_launch: occupancy query says %d\n", per_cu);
        (void)hipGetLastError();
        grid = cus;
    }
    if (grid < 0) return;
    (void)hipMemsetAsync((char*)d_ws + WS_CTL, 0, CTL_BYTES, stream);
    Args a{};
    for (int i = 0; i < 29; ++i) a.in[i] = (const float*)d_in[i];
    a.out = (float*)d_out; a.ws = (unsigned char*)d_ws;
#if MK_ONE_LAUNCH
    a.slab_lo = 0; a.slab_hi = NSLAB; a.ph_lo = 0; a.ph_hi = NSLAB * 2 * QPL; a.use_bar = 1; a.do_pro = 3;
    hipLaunchKernelGGL(fwd_kernel, dim3(grid), dim3(NWAVES * 64), LDS_BYTES, stream, a);
#else
    a.use_bar = 0;
    a.slab_lo = 0; a.slab_hi = 0; a.ph_lo = 0; a.ph_hi = 0; a.do_pro = 1;
    hipLaunchKernelGGL(fwd_kernel, dim3(grid), dim3(NWAVES * 64), LDS_BYTES, stream, a);
    a.do_pro = 2;
    hipLaunchKernelGGL(fwd_kernel, dim3(grid), dim3(NWAVES * 64), LDS_BYTES, stream, a);
    a.do_pro = 0;
    for (int slab = 0; slab < NSLAB; ++slab)
        for (int layer = 0; layer < 2; ++layer)
            for (int q = 0; q < QPL; ++q) {
                if ((layer == 0 ? ((q == 3 && slab < 2) || (q >= 6 && q <= 8)) : (q == 9)) || q == 14) continue;
                a.slab_lo = slab; a.slab_hi = slab + 1; a.ph_lo = (slab * 2 + layer) * QPL + q; a.ph_hi = a.ph_lo + 1;
                hipLaunchKernelGGL(fwd_kernel, dim3(grid), dim3(NWAVES * 64), LDS_BYTES, stream, a);
            }
#endif
}
```
